# Optimizing an MI355X kernel written in HIP

```python
import jax, jax.numpy as jnp
from jax import lax
import numpy as np

D_MODEL = 1024
BATCH = 2
SEQ = 16384
DEPTH = 4

GRID_W = 64
CTX_LEN = 256

N_GROUPS = 4
GROUP_W = D_MODEL // N_GROUPS
HEAD_DIM = GROUP_W // 4

SGU_HEADS = 4
SGU_CHUNK = 128
MLSTM_HEADS = 4
MLSTM_CHUNK = 128
QK_CONV = 3
ATT_HEADS = 4
ATT_KV_HEADS = 2
ATT_GROUP = ATT_HEADS // ATT_KV_HEADS
ATT_BLOCK = 128
WINDOW = 128
ROPE_BASE = 10000.0
AXIS_ROT = HEAD_DIM // 2
AXIS_FREQ = AXIS_ROT // 2
POOL_WINDOWS = (2, 4, 8, 16)
POOL_CH = GROUP_W // len(POOL_WINDOWS)
FFN_HIDDEN = -(-(8 * D_MODEL) // (3 * 256)) * 256

EPS = 1e-6

SGU_COLS = 2 * GROUP_W
MLSTM_COLS = 4 * GROUP_W + 4 * MLSTM_HEADS
ATT_Q = ATT_HEADS * HEAD_DIM
ATT_KV = ATT_KV_HEADS * HEAD_DIM
ATT_COLS = ATT_Q + 2 * ATT_KV
POOL_COLS = GROUP_W
OFF_MLSTM = SGU_COLS
OFF_ATT = OFF_MLSTM + MLSTM_COLS
OFF_POOL = OFF_ATT + ATT_COLS
IN_COLS = OFF_POOL + POOL_COLS

kernel_name = 'hybrid_parallel_groups_flow_backbone'

F32 = jnp.float32


def rms_norm(x, g):
    xf = x.astype(F32)
    y = xf * lax.rsqrt(jnp.mean(xf * xf, axis=-1, keepdims=True) + EPS)
    return (y * g.astype(F32)).astype(x.dtype)


def layer_norm(x):
    xf = x.astype(F32)
    mu = jnp.mean(xf, axis=-1, keepdims=True)
    xc = xf - mu
    return xc * lax.rsqrt(jnp.mean(xc * xc, axis=-1, keepdims=True) + EPS)


def modulate(h, shift, scale):
    return h * (1 + scale) + shift


def axial_rope_tables(n_tokens):
    rows = n_tokens // GRID_W
    row = jnp.broadcast_to(jnp.arange(rows)[:, None], (rows, GRID_W)).reshape(-1).astype(F32)
    col = jnp.broadcast_to(jnp.arange(GRID_W)[None, :], (rows, GRID_W)).reshape(-1).astype(F32)
    inv = jnp.power(ROPE_BASE, -jnp.arange(AXIS_FREQ, dtype=F32) * 2.0 / AXIS_ROT)
    ar = row[:, None] * inv
    ac = col[:, None] * inv
    ang = jnp.concatenate([ar, ar, ac, ac], axis=-1)
    return jnp.cos(ang), jnp.sin(ang)


def apply_rope(x, cos, sin):
    xs = x.reshape(x.shape[:-1] + (2, 2, AXIS_FREQ))
    rot = jnp.stack([-xs[..., 1, :], xs[..., 0, :]], axis=-2).reshape(x.shape)
    c = cos[None, :, None, :].astype(x.dtype)
    s = sin[None, :, None, :].astype(x.dtype)
    return x * c + rot * s


def spatial_gating(z, w_s, b_s):
    B, N, _ = z.shape
    z = jax.nn.gelu(z)
    u, v = z[..., :GROUP_W], z[..., GROUP_W:]
    nc = N // SGU_CHUNK
    vh = layer_norm(v.reshape(B, nc, SGU_CHUNK, SGU_HEADS, GROUP_W // SGU_HEADS)).astype(z.dtype)
    mixed = jnp.einsum('hts,bnshd->bnthd', w_s, vh) + b_s.T[None, None, :, :, None]
    return u * mixed.reshape(B, N, GROUP_W)


def short_conv(x, w):
    n = x.shape[1]
    p = QK_CONV // 2
    xp = jnp.pad(x, ((0, 0), (p, p), (0, 0)))
    out = xp[:, 0:n] * w[0]
    for j in range(1, QK_CONV):
        out = out + xp[:, j:j + n] * w[j]
    return out


def mlstm_chunk_scan(q, k, v, log_i, log_f, state):
    B, H, N, dh = q.shape
    nc = N // MLSTM_CHUNK

    def chunks(a):
        a = a.reshape((B, H, nc, MLSTM_CHUNK) + a.shape[3:])
        return jnp.moveaxis(a, 2, 0)

    tril = jnp.tril(jnp.ones((MLSTM_CHUNK, MLSTM_CHUNK), dtype=bool))

    def step(carry, xs):
        C, n, m = carry
        qc, kc, vc, li, lf = xs
        b = jnp.cumsum(lf, axis=-1)
        d_ts = jnp.where(tril, b[..., :, None] - b[..., None, :] + li[..., None, :], -jnp.inf)
        m_t = jnp.maximum(b + m[..., None], jnp.max(d_ts, axis=-1))
        inter = jnp.exp(b + m[..., None] - m_t)
        s = jnp.einsum('bhtd,bhsd->bhts', qc, kc) * jnp.exp(d_ts - m_t[..., None])
        num = inter[..., None] * jnp.einsum('bhtd,bhde->bhte', qc, C) + jnp.einsum('bhts,bhse->bhte', s, vc)
        den = inter * jnp.einsum('bhtd,bhd->bht', qc, n) + jnp.sum(s, axis=-1)
        h = num / jnp.maximum(jnp.abs(den), jnp.exp(-m_t))[..., None]
        b_end = b[..., -1]
        g = b_end[..., None] - b + li
        m_new = jnp.maximum(b_end + m, jnp.max(g, axis=-1))
        decay = jnp.exp(b_end + m - m_new)
        w = jnp.exp(g - m_new[..., None])
        C_new = decay[..., None, None] * C + jnp.einsum('bhs,bhsd,bhse->bhde', w, kc, vc)
        n_new = decay[..., None] * n + jnp.einsum('bhs,bhsd->bhd', w, kc)
        return (C_new, n_new, m_new), h

    state, hs = lax.scan(step, state, (chunks(q), chunks(k), chunks(v), chunks(log_i), chunks(log_f)))
    h = jnp.moveaxis(hs, 0, 2).reshape(B, H, N, dh)
    return h, state


def mlstm_prep(z, conv_w, gate_b):
    B, N, _ = z.shape
    G = GROUP_W
    qk = jax.nn.silu(short_conv(z[..., :2 * G], conv_w))

    def heads(a):
        return a.reshape(B, N, MLSTM_HEADS, -1).transpose(0, 2, 1, 3).astype(F32)

    q = heads(qk[..., :G])
    k = heads(qk[..., G:]) * (HEAD_DIM ** -0.5)
    v = heads(z[..., 2 * G:3 * G])
    o = jax.nn.sigmoid(z[..., 3 * G:4 * G])
    gates = (z[..., 4 * G:].astype(F32).reshape(B, N, 4, MLSTM_HEADS) + gate_b.astype(F32)).transpose(2, 0, 3, 1)
    gate_logs = (gates[0], jax.nn.log_sigmoid(gates[1]), gates[2], jax.nn.log_sigmoid(gates[3]))
    return q, k, v, o, gate_logs


def mlstm_directions(q, k, v, gate_logs, state_f, state_b):
    li_f, lf_f, li_b, lf_b = gate_logs
    h_f, st_f = mlstm_chunk_scan(q, k, v, li_f, lf_f, state_f)
    flip = lambda a: jnp.flip(a, axis=2)
    h_b, st_b = mlstm_chunk_scan(flip(q), flip(k), flip(v), flip(li_b), flip(lf_b), state_b)
    return h_f + flip(h_b), st_f, st_b


def mlstm_out(h, o, norm_g):
    B, H, N, dh = h.shape
    hn = layer_norm(h.transpose(0, 2, 1, 3)) * norm_g.astype(F32).reshape(H, dh)
    return hn.reshape(B, N, H * dh).astype(o.dtype) * o


def mlstm_mixer(zx, zc, conv_w, gate_b, norm_g, update_ctx):
    B = zx.shape[0]
    zero = (jnp.zeros((B, MLSTM_HEADS, HEAD_DIM, HEAD_DIM), F32),
            jnp.zeros((B, MLSTM_HEADS, HEAD_DIM), F32),
            jnp.zeros((B, MLSTM_HEADS), F32))
    qc, kc, vc, oc, gc = mlstm_prep(zc, conv_w, gate_b)
    h_c, st_f, st_b = mlstm_directions(qc, kc, vc, gc, zero, zero)
    qx, kx, vx, ox, gx = mlstm_prep(zx, conv_w, gate_b)
    h_x, _, _ = mlstm_directions(qx, kx, vx, gx, st_f, st_b)
    out_x = mlstm_out(h_x, ox, norm_g)
    out_c = mlstm_out(h_c, oc, norm_g) if update_ctx else None
    return out_x, out_c


def band_attention(q, k, v, k_ctx, v_ctx, sink):
    B, N = q.shape[:2]
    L = ATT_BLOCK
    nb = N // L
    scale = HEAD_DIM ** -0.5
    qb = q.reshape(B, nb, L, ATT_KV_HEADS, ATT_GROUP, HEAD_DIM)
    pad = ((0, 0), (L, L), (0, 0), (0, 0))
    kp = jnp.pad(k, pad).reshape(B, nb + 2, L, ATT_KV_HEADS, HEAD_DIM)
    vp = jnp.pad(v, pad).reshape(B, nb + 2, L, ATT_KV_HEADS, HEAD_DIM)
    band = lambda a: jnp.concatenate([a[:, :-2], a[:, 1:-1], a[:, 2:]], axis=2)
    kb, vb = band(kp), band(vp)
    s_loc = jnp.einsum('bnqhgd,bnshd->bnhgqs', qb, kb).astype(F32) * scale
    s_ctx = jnp.einsum('bnqhgd,bchd->bnhgqc', qb, k_ctx).astype(F32) * scale
    qpos = jnp.arange(nb)[:, None] * L + jnp.arange(L)[None, :]
    kpos = (jnp.arange(nb)[:, None] - 1) * L + jnp.arange(3 * L)[None, :]
    valid = (jnp.abs(qpos[:, :, None] - kpos[:, None, :]) <= WINDOW) & ((kpos >= 0) & (kpos < N))[:, None, :]
    s_loc = jnp.where(valid[None, :, None, None], s_loc, -jnp.inf)
    s_sink = jnp.broadcast_to(sink.astype(F32).reshape(ATT_KV_HEADS, ATT_GROUP)[None, None, :, :, None, None],
                              s_loc.shape[:-1] + (1,))
    p = jax.nn.softmax(jnp.concatenate([s_loc, s_ctx, s_sink], axis=-1), axis=-1).astype(v.dtype)
    n_loc = 3 * L
    n_ctx = k_ctx.shape[1]
    o = (jnp.einsum('bnhgqs,bnshd->bnqhgd', p[..., :n_loc], vb)
         + jnp.einsum('bnhgqc,bchd->bnqhgd', p[..., n_loc:n_loc + n_ctx], v_ctx))
    return o.reshape(B, N, ATT_HEADS * HEAD_DIM)


def context_attention(q, k, v, sink):
    B, C = q.shape[:2]
    qg = q.reshape(B, C, ATT_KV_HEADS, ATT_GROUP, HEAD_DIM)
    s = jnp.einsum('bqhgd,bchd->bhgqc', qg, k).astype(F32) * (HEAD_DIM ** -0.5)
    s_sink = jnp.broadcast_to(sink.astype(F32).reshape(ATT_KV_HEADS, ATT_GROUP)[None, :, :, None, None],
                              s.shape[:-1] + (1,))
    p = jax.nn.softmax(jnp.concatenate([s, s_sink], axis=-1), axis=-1)[..., :-1].astype(v.dtype)
    return jnp.einsum('bhgqc,bchd->bqhgd', p, v).reshape(B, C, ATT_HEADS * HEAD_DIM)


def attn_mixer(zx, zc, cos, sin, sink, update_ctx):
    def split(z):
        B, N, _ = z.shape
        q = z[..., :ATT_Q].reshape(B, N, ATT_HEADS, HEAD_DIM)
        k = z[..., ATT_Q:ATT_Q + ATT_KV].reshape(B, N, ATT_KV_HEADS, HEAD_DIM)
        v = z[..., ATT_Q + ATT_KV:].reshape(B, N, ATT_KV_HEADS, HEAD_DIM)
        return q, k, v
    qx, kx, vx = split(zx)
    qc, kc, vc = split(zc)
    out_x = band_attention(apply_rope(qx, cos, sin), apply_rope(kx, cos, sin), vx, kc, vc, sink)
    out_c = context_attention(qc, kc, vc, sink) if update_ctx else None
    return out_x, out_c


def pool_mixer(z, pool_w, pool_scale):
    B, N, _ = z.shape
    zg = z.astype(F32).reshape(B, N, len(POOL_WINDOWS), POOL_CH)
    csum = jnp.concatenate([jnp.zeros((B, 1) + zg.shape[2:], F32), jnp.cumsum(zg, axis=1)], axis=1)
    t = jnp.arange(N)
    means = []
    for gi, w in enumerate(POOL_WINDOWS):
        lo = jnp.clip(t - w // 2, 0, N)
        hi = jnp.clip(t + w - w // 2, 0, N)
        cnt = (hi - lo).astype(F32)
        means.append((csum[:, hi, gi] - csum[:, lo, gi]) / cnt[None, :, None])
    pooled = jnp.stack(means, axis=2)
    y = jnp.einsum('bngc,gcd->bngd', (pooled - zg).astype(z.dtype), pool_w)
    return y.reshape(B, N, GROUP_W) * pool_scale


def token_mixers(zx, zc, cos, sin, sgu_w, sgu_b, conv_w, gate_b, mnorm_g, sink, pool_w, pool_scale, update_ctx):
    seg = lambda z, a, b: z[..., a:b]
    a_x = spatial_gating(seg(zx, 0, OFF_MLSTM), sgu_w, sgu_b)
    b_x, b_c = mlstm_mixer(seg(zx, OFF_MLSTM, OFF_ATT), seg(zc, OFF_MLSTM, OFF_ATT), conv_w, gate_b, mnorm_g, update_ctx)
    c_x, c_c = attn_mixer(seg(zx, OFF_ATT, OFF_POOL), seg(zc, OFF_ATT, OFF_POOL), cos, sin, sink, update_ctx)
    d_x = pool_mixer(seg(zx, OFF_POOL, IN_COLS), pool_w, pool_scale)
    out_x = jnp.concatenate([a_x, b_x, c_x, d_x], axis=-1)
    out_c = None
    if update_ctx:
        a_c = spatial_gating(seg(zc, 0, OFF_MLSTM), sgu_w, sgu_b)
        d_c = pool_mixer(seg(zc, OFF_POOL, IN_COLS), pool_w, pool_scale)
        out_c = jnp.concatenate([a_c, b_c, c_c, d_c], axis=-1)
    return out_x, out_c


def swiglu(h, w_in_, w_out_):
    gate, up = jnp.split(h @ w_in_, 2, axis=-1)
    return (jax.nn.silu(gate) * up) @ w_out_


def trunk_layer(x, ctx, c, c_ctx, cos, sin, w_mod, b_mod, norm_g, w_in, w_out, sgu_w, sgu_b, conv_w, gate_b,
                mnorm_g, sink, pool_w, pool_scale, w_ffn_in, w_ffn_out, update_ctx):
    sh_a, sc_a, g_a, sh_f, sc_f, g_f = jnp.split((jax.nn.silu(c) @ w_mod + b_mod)[:, None, :], 6, axis=-1)
    csh_a, csc_a, cg_a, csh_f, csc_f, cg_f = jnp.split((jax.nn.silu(c_ctx) @ w_mod + b_mod)[None, None, :], 6, axis=-1)
    zx = modulate(rms_norm(x, norm_g[0]), sh_a, sc_a) @ w_in
    zc = modulate(rms_norm(ctx, norm_g[0]), csh_a, csc_a) @ w_in
    mix_x, mix_c = token_mixers(zx, zc, cos, sin, sgu_w, sgu_b, conv_w, gate_b, mnorm_g, sink, pool_w, pool_scale,
                                update_ctx)
    x = x + g_a * rms_norm(mix_x @ w_out, norm_g[1])
    x = x + g_f * rms_norm(swiglu(modulate(rms_norm(x, norm_g[2]), sh_f, sc_f), w_ffn_in, w_ffn_out), norm_g[3])
    if update_ctx:
        ctx = ctx + cg_a * rms_norm(mix_c @ w_out, norm_g[1])
        ctx = ctx + cg_f * rms_norm(swiglu(modulate(rms_norm(ctx, norm_g[2]), csh_f, csc_f), w_ffn_in, w_ffn_out),
                                    norm_g[3])
    return x, ctx


def setup_inputs(seed: int = 0) -> dict:
    key = jax.random.key(seed)
    ks = jax.random.split(key, 19)
    nrm = lambda k, shape, s: jax.random.normal(k, shape, F32) * s
    x = nrm(ks[0], (BATCH, SEQ, D_MODEL), 1.0)
    c = nrm(ks[1], (BATCH, D_MODEL), 1.0)
    ctx = nrm(ks[2], (BATCH, CTX_LEN, D_MODEL), 1.0)
    c_ctx = nrm(ks[3], (D_MODEL,), 1.0)
    w_mod = nrm(ks[4], (DEPTH, D_MODEL, 6 * D_MODEL), 0.5 * D_MODEL ** -0.5)
    b_mod = nrm(ks[5], (DEPTH, 6 * D_MODEL), 0.02)
    norm_g = 1.0 + nrm(ks[6], (DEPTH, 4, D_MODEL), 0.05)
    w_in = nrm(ks[7], (DEPTH, D_MODEL, IN_COLS), D_MODEL ** -0.5)
    w_out = nrm(ks[8], (DEPTH, D_MODEL, D_MODEL), D_MODEL ** -0.5)
    sgu_w = nrm(ks[9], (DEPTH, SGU_HEADS, SGU_CHUNK, SGU_CHUNK), SGU_CHUNK ** -0.5)
    sgu_b = 1.0 + nrm(ks[10], (DEPTH, SGU_HEADS, SGU_CHUNK), 0.05)
    mlstm_conv_w = nrm(ks[11], (DEPTH, QK_CONV, 2 * GROUP_W), QK_CONV ** -0.5)
    f_bias = jnp.linspace(3.0, 6.0, MLSTM_HEADS)
    is_forget = jnp.array([0.0, 1.0, 0.0, 1.0], dtype=F32)
    mlstm_gate_b = nrm(ks[12], (DEPTH, 4, MLSTM_HEADS), 0.1) + is_forget[None, :, None] * f_bias[None, None, :]
    mlstm_norm_g = 1.0 + nrm(ks[13], (DEPTH, GROUP_W), 0.05)
    attn_sink = nrm(ks[14], (DEPTH, ATT_HEADS), 1.0)
    pool_w = nrm(ks[15], (DEPTH, len(POOL_WINDOWS), POOL_CH, POOL_CH), POOL_CH ** -0.5)
    pool_scale = 1.0 + nrm(ks[16], (DEPTH, GROUP_W), 0.1)
    w_ffn_in = nrm(ks[17], (DEPTH, D_MODEL, 2 * FFN_HIDDEN), D_MODEL ** -0.5)
    w_ffn_out = nrm(ks[18], (DEPTH, FFN_HIDDEN, D_MODEL), FFN_HIDDEN ** -0.5)
    return {'x': x, 'c': c, 'ctx': ctx, 'c_ctx': c_ctx, 'w_mod': w_mod, 'b_mod': b_mod, 'norm_g': norm_g,
            'w_in': w_in, 'w_out': w_out, 'sgu_w': sgu_w, 'sgu_b': sgu_b, 'mlstm_conv_w': mlstm_conv_w,
            'mlstm_gate_b': mlstm_gate_b, 'mlstm_norm_g': mlstm_norm_g, 'attn_sink': attn_sink,
            'pool_w': pool_w, 'pool_scale': pool_scale, 'w_ffn_in': w_ffn_in, 'w_ffn_out': w_ffn_out}


def reference(x, c, ctx, c_ctx, w_mod, b_mod, norm_g, w_in, w_out, sgu_w, sgu_b, mlstm_conv_w, mlstm_gate_b,
              mlstm_norm_g, attn_sink, pool_w, pool_scale, w_ffn_in, w_ffn_out):
    cos, sin = axial_rope_tables(x.shape[1])
    for l in range(DEPTH):
        x, ctx = trunk_layer(x, ctx, c, c_ctx, cos, sin, w_mod[l], b_mod[l], norm_g[l], w_in[l], w_out[l],
                             sgu_w[l], sgu_b[l], mlstm_conv_w[l], mlstm_gate_b[l], mlstm_norm_g[l], attn_sink[l],
                             pool_w[l], pool_scale[l], w_ffn_in[l], w_ffn_out[l], l < DEPTH - 1)
    return x
```

```cpp
#include <hip/hip_runtime.h>
#include <hip/hip_cooperative_groups.h>
#include <cstdio>
namespace cg = cooperative_groups;

#define LAS __attribute__((address_space(3)))
#define DEV __device__ __forceinline__
typedef unsigned short bf16_t;
typedef short bf16x8 __attribute__((ext_vector_type(8)));
typedef float f32x4 __attribute__((ext_vector_type(4)));
typedef unsigned u32x4 __attribute__((ext_vector_type(4)));
typedef unsigned u32x2 __attribute__((ext_vector_type(2)));

constexpr int D = 1024, NB = 2, SEQ = 16384, CTXL = 256, DEPTH = 4;
constexpr int RPB = SEQ + CTXL;
constexpr int MROWS = NB * RPB;
constexpr int NCH = RPB / 128;
constexpr int ZS = 2560;
constexpr int INC = 2320;
constexpr int FH = 2816;
constexpr int ZC_SGU = 0, ZC_MQ = 512, ZC_MK = 768, ZC_MV = 1024, ZC_MO = 1280, ZC_MG = 1536;
constexpr int ZC_AQ = 1552, ZC_AK = 1808, ZC_AV = 1936, ZC_POOL = 2064;
constexpr float EPS = 1e-6f;

constexpr size_t WS_A = 0;
constexpr size_t SZ_ACT = (size_t)MROWS * D * 2;
constexpr size_t WS_Y = WS_A + SZ_ACT;
constexpr size_t WS_Z = WS_Y + SZ_ACT;
constexpr size_t WS_MIX = WS_Z + (size_t)MROWS * ZS * 2;
constexpr size_t WS_H = WS_Z;
constexpr size_t WS_W = WS_MIX + SZ_ACT;
constexpr size_t SZ_WIN = (size_t)ZS * D * 2, SZ_WOUT = (size_t)D * D * 2, SZ_WFI = (size_t)2 * FH * D * 2, SZ_WFO = (size_t)D * FH * 2;
constexpr size_t SZ_WL = SZ_WIN + SZ_WOUT + SZ_WFI + SZ_WFO;
constexpr size_t WS_CL = WS_W + DEPTH * SZ_WL;
constexpr size_t WS_NL = WS_CL + (size_t)16 * NCH * 4096 * 4;
constexpr size_t WS_SC = WS_NL + (size_t)16 * NCH * 64 * 4;
constexpr size_t WS_MOD = WS_SC + 32768;
constexpr size_t WS_CTXR = WS_MOD + (size_t)DEPTH * 3 * 6144 * 4;
constexpr size_t WS_ROPE = WS_CTXR + (size_t)NB * CTXL * D * 4;
constexpr size_t WS_BAR = WS_ROPE + 40960;
constexpr size_t WS_END = WS_BAR + 16384;
static_assert(WS_H + (size_t)MROWS * FH * 2 <= WS_W, "H alias");

constexpr int NTHR = 512;
constexpr int LDS_BYTES = 135168;

DEV unsigned f2bf(float f) { unsigned u = __builtin_bit_cast(unsigned, f); return (u + 0x7fffu + ((u >> 16) & 1u)) >> 16; }
DEV unsigned pk2(float lo, float hi) { unsigned r; asm("v_cvt_pk_bf16_f32 %0, %1, %2" : "=v"(r) : "v"(lo), "v"(hi)); return r; }
DEV float bf2f(unsigned v) { return __builtin_bit_cast(float, v << 16); }
DEV void unpack8(u32x4 v, float* o) {
#pragma unroll
    for (int i = 0; i < 4; ++i) { o[2 * i] = bf2f(v[i] & 0xffffu); o[2 * i + 1] = __builtin_bit_cast(float, v[i] & 0xffff0000u); }
}
DEV void unpack4(u32x2 v, float* o) {
#pragma unroll
    for (int i = 0; i < 2; ++i) { o[2 * i] = bf2f(v[i] & 0xffffu); o[2 * i + 1] = __builtin_bit_cast(float, v[i] & 0xffff0000u); }
}
DEV float fsigmoid(float x) { return __builtin_amdgcn_rcpf(1.f + __expf(-x)); }
DEV float fsilu(float x) { return x * fsigmoid(x); }
DEV float fgelu(float x) { const float y = 0.7978845608f * (x + 0.044715f * x * x * x); const float t = 1.f - 2.f * __builtin_amdgcn_rcpf(__expf(2.f * y) + 1.f); return 0.5f * x * (1.f + t); }
DEV float logsigmoid(float x) { return fminf(x, 0.f) - log1pf(__expf(-fabsf(x))); }
#define DPPF(idbits, v, ctrl, rmask) __builtin_bit_cast(float, __builtin_amdgcn_update_dpp((int)(idbits), __builtin_bit_cast(int, (v)), (ctrl), (rmask), 0xf, false))
DEV float red4_add(float v) { v += __shfl_xor(v, 16); v += __shfl_xor(v, 32); return v; }
DEV float red4_max(float v) { v = fmaxf(v, __shfl_xor(v, 16)); v = fmaxf(v, __shfl_xor(v, 32)); return v; }
DEV float wave_sum(float v) {
    v += DPPF(0, v, 0x128, 0xf); v += DPPF(0, v, 0x124, 0xf); v += DPPF(0, v, 0x122, 0xf); v += DPPF(0, v, 0x121, 0xf);
    return red4_add(v);
}
DEV float wave_max(float v) {
    v = fmaxf(v, DPPF(0xff800000u, v, 0x128, 0xf)); v = fmaxf(v, DPPF(0xff800000u, v, 0x124, 0xf)); v = fmaxf(v, DPPF(0xff800000u, v, 0x122, 0xf)); v = fmaxf(v, DPPF(0xff800000u, v, 0x121, 0xf));
    return red4_max(v);
}
DEV float wave_scan_add(float v, int lane) {
    (void)lane;
    v += DPPF(0, v, 0x111, 0xf); v += DPPF(0, v, 0x112, 0xf); v += DPPF(0, v, 0x114, 0xf); v += DPPF(0, v, 0x118, 0xf);
    v += DPPF(0, v, 0x142, 0xa); v += DPPF(0, v, 0x143, 0xc);
    return v;
}
DEV float wave_scan_max(float v, int lane) {
    (void)lane;
    v = fmaxf(v, DPPF(0xff800000u, v, 0x111, 0xf)); v = fmaxf(v, DPPF(0xff800000u, v, 0x112, 0xf)); v = fmaxf(v, DPPF(0xff800000u, v, 0x114, 0xf)); v = fmaxf(v, DPPF(0xff800000u, v, 0x118, 0xf));
    v = fmaxf(v, DPPF(0xff800000u, v, 0x142, 0xa)); v = fmaxf(v, DPPF(0xff800000u, v, 0x143, 0xc));
    return v;
}
DEV float cummax_prev(float cm) { return fmaxf(DPPF(0xff800000u, cm, 0x111, 0xf), DPPF(0xff800000u, cm, 0x142, 0xe)); }
typedef short v4s __attribute__((ext_vector_type(4)));
DEV bf16x8 tr_frag(const LAS bf16_t* T, int ld, int k0, int n0, int lane) {
    const int g = lane >> 4, q = (lane & 15) >> 2, p = lane & 3;
    const LAS bf16_t* a0 = T + (k0 + 8 * g + q) * ld + n0 + 4 * p;
    const v4s lo = __builtin_amdgcn_ds_read_tr16_b64_v4i16((LAS v4s*)a0), hi = __builtin_amdgcn_ds_read_tr16_b64_v4i16((LAS v4s*)(a0 + 4 * ld));
    return __builtin_shufflevector(lo, hi, 0, 1, 2, 3, 4, 5, 6, 7);
}
template <int K>
DEV f32x4 mma_nt(const LAS bf16_t* X, int ldx, const LAS bf16_t* Y, int ldy, f32x4 acc, int fr, int fq) {
#pragma unroll
    for (int k0 = 0; k0 < K; k0 += 32) {
        const bf16x8 xf = *(const LAS bf16x8*)(X + fr * ldx + k0 + fq * 8);
        const bf16x8 yf = *(const LAS bf16x8*)(Y + fr * ldy + k0 + fq * 8);
        acc = __builtin_amdgcn_mfma_f32_16x16x32_bf16(yf, xf, acc, 0, 0, 0);
    }
    return acc;
}

namespace pg8 {
constexpr int BM = 256, BK = 64, HALF = 128, HTB = HALF * BK * 2, STAGE_BYTES = 8 * HTB, NXCD = 8, WGM = 8;
DEV int lds_byte(int r, int c) { const int st = (r >> 4) * 2 + (c >> 5), rr = r & 15, cc = c & 31, ob = rr * 64 + cc * 2; return st * 1024 + (ob ^ (((ob >> 9) & 1) << 5)); }
DEV void stage_rc(int b, int& R, int& C) { const int st = b / 1024, sb = b % 1024, swz = sb ^ (((sb >> 9) & 1) << 5); R = (st >> 1) * 16 + swz / 64; C = (st & 1) * 32 + (swz % 64) / 2; }
DEV int perm32(int rho) { const int n = rho >> 4, i = rho & 15; return 8 * (i >> 2) + 4 * n + (i & 3); }
struct Unit { int pm, pn; };
DEV int prow(int pm) { return pm * 256 + 256 + ((pm >> 6) << 8); }
struct Gemm { const bf16_t* A; const bf16_t* Bt; int M, N, K; };
struct StaticOrder {
    int nM, nN, nwg, G, c;
    DEV void init(int M, int N, int G_, int c_) { nM = M / BM; nN = N / BM; nwg = nM * nN; G = G_; c = c_; }
    DEV bool next(int i, Unit& u) const {
        const long L = (long)i * G + c; if (L >= nwg) return false;
        int wgid = (int)L; { const int q = nwg / NXCD, r = nwg % NXCD, xcd = wgid % NXCD, off = wgid / NXCD; wgid = (xcd < r ? xcd * (q + 1) : r * (q + 1) + (xcd - r) * q) + off; }
        const int nig = WGM * nN, gid = wgid / nig, fm = gid * WGM, gsz = (nM - fm) < WGM ? (nM - fm) : WGM;
        u.pm = fm + ((wgid % nig) % gsz); u.pn = (wgid % nig) / gsz; return true;
    }
};
DEV unsigned cvt_pk_bf16(float lo, float hi) { unsigned r; asm volatile("v_cvt_pk_bf16_f32 %0, %1, %2" : "=v"(r) : "v"(lo), "v"(hi)); return r; }
struct EpiBf16 {
    bf16_t* O; int ldc;
    DEV void operator()(const f32x4 (&acc)[2][2][4][2], const Unit& u, int wr, int wc, int fr, int fq) const {
        const int row0 = prow(u.pm) + wr * 64 + fr; const int col0 = u.pn * BM + wc * 32 + 8 * fq;
#pragma unroll
        for (int ai = 0; ai < 2; ++ai)
#pragma unroll
            for (int m = 0; m < 4; ++m) { bf16_t* rowp = O + (size_t)(row0 + ai * HALF + m * 16) * ldc + col0;
#pragma unroll
                for (int bj = 0; bj < 2; ++bj) { const f32x4 v0 = acc[ai][bj][m][0], v1 = acc[ai][bj][m][1];
                    u32x4 w; w.x = cvt_pk_bf16(v0[0], v0[1]); w.y = cvt_pk_bf16(v0[2], v0[3]); w.z = cvt_pk_bf16(v1[0], v1[1]); w.w = cvt_pk_bf16(v1[2], v1[3]);
                    *(u32x4*)(rowp + bj * HALF) = w; } }
    }
};
struct EpiSwiglu {
    bf16_t* O;
    DEV void operator()(const f32x4 (&acc)[2][2][4][2], const Unit& u, int wr, int wc, int fr, int fq) const {
        const int row0 = prow(u.pm) + wr * 64 + fr; const int col0 = u.pn * HALF + wc * 32 + 8 * fq;
#pragma unroll
        for (int ai = 0; ai < 2; ++ai)
#pragma unroll
            for (int m = 0; m < 4; ++m) { bf16_t* rowp = O + (size_t)(row0 + ai * HALF + m * 16) * FH + col0;
                typedef float f32x2 __attribute__((ext_vector_type(2)));
                f32x2 gv[4], uv[4], ev[4], ov[4];
#pragma unroll
                for (int q = 0; q < 4; ++q) { const int n = q >> 1, j = (q & 1) * 2; gv[q] = (f32x2){acc[ai][0][m][n][j], acc[ai][0][m][n][j + 1]}; uv[q] = (f32x2){acc[ai][1][m][n][j], acc[ai][1][m][n][j + 1]}; }
#pragma unroll
                for (int q = 0; q < 4; ++q) { const f32x2 t = gv[q] * -1.44269504089f; ev[q].x = __builtin_amdgcn_exp2f(t.x); ev[q].y = __builtin_amdgcn_exp2f(t.y); }
#pragma unroll
                for (int q = 0; q < 4; ++q) { const f32x2 d = ev[q] + 1.0f; f32x2 r; r.x = __builtin_amdgcn_rcpf(d.x); r.y = __builtin_amdgcn_rcpf(d.y); ov[q] = (gv[q] * r) * uv[q]; }
                float o[8];
#pragma unroll
                for (int q = 0; q < 4; ++q) { o[2 * q] = ov[q].x; o[2 * q + 1] = ov[q].y; }
                u32x4 w; w.x = cvt_pk_bf16(o[0], o[1]); w.y = cvt_pk_bf16(o[2], o[3]); w.z = cvt_pk_bf16(o[4], o[5]); w.w = cvt_pk_bf16(o[6], o[7]);
                *(u32x4*)rowp = w; }
    }
};

template <class Epi>
DEV void gemm_phase(LAS unsigned char* lds, const int tid, const Gemm g, const StaticOrder& S, const Epi& E) {
    const int wid = __builtin_amdgcn_readfirstlane(tid >> 6), lane = tid & 63, wr = wid >> 2, wc = wid & 3, fr = lane & 15, fq = lane >> 4;
    const int K = g.K, nt = K / BK;
    unsigned voffA[2], voffB[2];
#pragma unroll
    for (int i = 0; i < 2; ++i) { int R, C; stage_rc(tid * 16 + i * 8192, R, C); const int Rb = (R & ~31) + perm32(R & 31);
        voffA[i] = (unsigned)(R * K + C) * 2u; voffB[i] = (unsigned)(Rb * K + C) * 2u; }
    const size_t kstep = (size_t)(BK * 2);
    const size_t hstep = (size_t)HALF * K * 2;
    const size_t tstep = 2 * hstep;
    const unsigned ldsw = (unsigned)wid * 1024u;
    const int aoff = lds_byte(wr * 64 + fr, fq * 8), boff = lds_byte(wc * 32 + fr, fq * 8);
#define PG8_SA(b, h) (((b) * 2 + (h)) * HTB)
#define PG8_SB(b, h) ((4 + (b) * 2 + (h)) * HTB)
#define PG8_STAGE(bufoff, gbase, voff) do { _Pragma("unroll") for (int _i = 0; _i < 2; ++_i) \
        __builtin_amdgcn_global_load_lds((const unsigned*)((const char*)(gbase) + (voff)[_i]), (LAS unsigned*)(lds + (bufoff) + ldsw + _i * 8192), 16, 0, 0); } while (0)
#define PG8_LDA(dst, b, h) do { _Pragma("unroll") for (int m = 0; m < 4; ++m) _Pragma("unroll") for (int k = 0; k < 2; ++k) dst[m][k] = *(const LAS bf16x8*)(lds + PG8_SA(b, h) + aoff + m * 2048 + k * 1024); } while (0)
#define PG8_LDB(dst, b, h) do { _Pragma("unroll") for (int n = 0; n < 2; ++n) _Pragma("unroll") for (int k = 0; k < 2; ++k) dst[n][k] = *(const LAS bf16x8*)(lds + PG8_SB(b, h) + boff + n * 2048 + k * 1024); } while (0)
#define PG8_MMA(ai, bj, At, Bt) do { __builtin_amdgcn_s_setprio(1); _Pragma("unroll") for (int m = 0; m < 4; ++m) _Pragma("unroll") for (int n = 0; n < 2; ++n) _Pragma("unroll") for (int k = 0; k < 2; ++k) \
        acc[ai][bj][m][n] = __builtin_amdgcn_mfma_f32_16x16x32_bf16(Bt[n][k], At[m][k], acc[ai][bj][m][n], 0, 0, 0); __builtin_amdgcn_s_setprio(0); } while (0)
#define PG8_WAIT_V(n) asm volatile("s_waitcnt vmcnt(" #n ")" ::: "memory")
#define PG8_WAIT_L(n) asm volatile("s_waitcnt lgkmcnt(" #n ")" ::: "memory")
#define PG8_BAR __builtin_amdgcn_s_barrier()
#define PG8_SCHED __builtin_amdgcn_sched_barrier(0)
    Unit cur, nxt; int ui = 0;
    if (!S.next(0, cur)) return;
    f32x4 acc[2][2][4][2];
#pragma unroll
    for (int a = 0; a < 2; ++a)
#pragma unroll
        for (int b = 0; b < 2; ++b)
#pragma unroll
            for (int m = 0; m < 4; ++m)
#pragma unroll
                for (int n = 0; n < 2; ++n) acc[a][b][m][n] = (f32x4){0.f, 0.f, 0.f, 0.f};
    bf16x8 At[4][2], B0[2][2], B1[2][2];
    const char* cA = (const char*)g.A + (size_t)prow(cur.pm) * K * 2; const char* cB = (const char*)g.Bt + (size_t)cur.pn * tstep;
    PG8_STAGE(PG8_SB(0, 0), cB, voffB); PG8_STAGE(PG8_SA(0, 0), cA, voffA); PG8_STAGE(PG8_SB(0, 1), cB + hstep, voffB); PG8_STAGE(PG8_SA(0, 1), cA + hstep, voffA);
    if (wr == 1) PG8_BAR;
    PG8_WAIT_V(4); PG8_BAR;
    PG8_STAGE(PG8_SB(1, 0), cB + kstep, voffB); PG8_STAGE(PG8_SA(1, 0), cA + kstep, voffA); PG8_STAGE(PG8_SB(1, 1), cB + hstep + kstep, voffB);
    PG8_WAIT_V(6); PG8_BAR;
    for (;;) {
        const bool has_next = S.next(ui + 1, nxt);
        const char* nA = has_next ? (const char*)g.A + (size_t)prow(nxt.pm) * K * 2 : cA; const char* nB = has_next ? (const char*)g.Bt + (size_t)nxt.pn * tstep : cB;
        for (int t = 0; t < nt; t += 2) {
            const bool last = (t == nt - 2);
            const char* a1 = cA + (size_t)(t + 1) * kstep;
            const char* a2 = last ? nA : cA + (size_t)(t + 2) * kstep; const char* b2 = last ? nB : cB + (size_t)(t + 2) * kstep;
            const char* a3 = a2 + kstep; const char* b3 = b2 + kstep;
            PG8_LDB(B0, 0, 0); PG8_SCHED; PG8_LDA(At, 0, 0); PG8_STAGE(PG8_SA(1, 1), a1 + hstep, voffA);
            PG8_WAIT_L(8); PG8_BAR; PG8_WAIT_L(0); PG8_MMA(0, 0, At, B0); PG8_BAR; PG8_SCHED;
            PG8_LDB(B1, 0, 1); PG8_STAGE(PG8_SB(0, 0), b2, voffB);
            PG8_BAR; PG8_WAIT_L(0); PG8_MMA(0, 1, At, B1); PG8_BAR;
            PG8_LDA(At, 0, 1); PG8_STAGE(PG8_SA(0, 0), a2, voffA);
            PG8_BAR; PG8_WAIT_L(0); PG8_MMA(1, 0, At, B0); PG8_BAR; PG8_SCHED;
            PG8_STAGE(PG8_SB(0, 1), b2 + hstep, voffB);
            PG8_WAIT_V(6); PG8_BAR; PG8_MMA(1, 1, At, B1); PG8_BAR;
            PG8_LDB(B0, 1, 0); PG8_SCHED; PG8_LDA(At, 1, 0); PG8_STAGE(PG8_SA(0, 1), a2 + hstep, voffA);
            PG8_WAIT_L(8); PG8_BAR; PG8_WAIT_L(0); PG8_MMA(0, 0, At, B0); PG8_BAR; PG8_SCHED;
            PG8_LDB(B1, 1, 1); PG8_STAGE(PG8_SB(1, 0), b3, voffB);
            PG8_BAR; PG8_WAIT_L(0); PG8_MMA(0, 1, At, B1); PG8_BAR;
            PG8_LDA(At, 1, 1); PG8_STAGE(PG8_SA(1, 0), a3, voffA);
            PG8_BAR; PG8_WAIT_L(0); PG8_MMA(1, 0, At, B0); PG8_BAR; PG8_SCHED;
            PG8_STAGE(PG8_SB(1, 1), b3 + hstep, voffB);
            PG8_WAIT_V(6); PG8_BAR; PG8_MMA(1, 1, At, B1); PG8_BAR;
        }
        E(acc, cur, wr, wc, fr, fq);
        if (!has_next) break;
#pragma unroll
        for (int a = 0; a < 2; ++a)
#pragma unroll
            for (int b = 0; b < 2; ++b)
#pragma unroll
                for (int m = 0; m < 4; ++m)
#pragma unroll
                    for (int n = 0; n < 2; ++n) acc[a][b][m][n] = (f32x4){0.f, 0.f, 0.f, 0.f};
        cur = nxt; cA = nA; cB = nB; ++ui;
    }
    PG8_WAIT_V(0);
    if (wr == 0) PG8_BAR;
    PG8_BAR;
#undef PG8_SA
#undef PG8_SB
#undef PG8_STAGE
#undef PG8_LDA
#undef PG8_LDB
#undef PG8_MMA
#undef PG8_WAIT_V
#undef PG8_WAIT_L
#undef PG8_BAR
#undef PG8_SCHED
}
}

struct Args { const float* in[19]; float* out; unsigned char* ws; };
struct Fr {
    const float* in[19]; float* out; unsigned char* ws;
    bf16_t *A, *Y, *Z, *MIX, *H, *XB; float *CL, *NL, *AL, *BE, *MS, *MOD, *CTXR; float* ROPE;
    LAS unsigned char* lds;
    int tid, lane, wave, G, bid;
};
enum { I_X = 0, I_C, I_CTX, I_CCTX, I_WMOD, I_BMOD, I_NORMG, I_WIN, I_WOUT, I_SGUW, I_SGUB, I_CONVW, I_GATEB, I_MNORMG, I_SINK, I_POOLW, I_POOLS, I_WFI, I_WFO };

DEV bf16_t* wt_ptr(const Fr& F, int l, int which) {
    size_t off = WS_W + (size_t)l * SZ_WL;
    if (which >= 1) off += SZ_WIN; if (which >= 2) off += SZ_WOUT; if (which >= 3) off += SZ_WFI;
    return (bf16_t*)(F.ws + off);
}


template <int CH>
DEV void cg_chunk(f32x4 (&acc)[4][4], const bf16_t* ap, const bf16_t* bp, const int (&brow)[4], int K) {
    bf16x8 a[CH][4], b[CH][4];
#pragma unroll
    for (int c = 0; c < CH; ++c)
#pragma unroll
        for (int i = 0; i < 4; ++i) { a[c][i] = *(const bf16x8*)(ap + (size_t)(16 * i) * K + 32 * c); b[c][i] = *(const bf16x8*)(bp + (size_t)brow[i] * K + 32 * c); }
#pragma unroll
    for (int c = 0; c < CH; ++c)
#pragma unroll
        for (int mi = 0; mi < 4; ++mi)
#pragma unroll
            for (int ni = 0; ni < 4; ++ni) acc[mi][ni] = __builtin_amdgcn_mfma_f32_16x16x32_bf16(b[c][ni], a[c][mi], acc[mi][ni], 0, 0, 0);
}
template <int MODE>
DEV void cgemm_tile(const Fr& F, const bf16_t* A, const bf16_t* Bt, int K, int rb, int cb, bf16_t* O, int ldc) {
    LAS float* part = (LAS float*)F.lds;
    const int w = F.wave, fr = F.lane & 15, fq = F.lane >> 4;
    const int arow0 = (rb >> 2) * RPB + (rb & 3) * 64;
    int brow[4];
#pragma unroll
    for (int ni = 0; ni < 4; ++ni) {
        if (MODE == 0) brow[ni] = cb * 64 + ni * 16;
        else { const int j = cb * 32 + (ni & 1) * 16; brow[ni] = (j >> 7) * 256 + (ni >> 1) * 128 + (j & 127); }
    }
    const int kslice = K >> 3, steps = kslice >> 5;
    const bf16_t* ap = A + (size_t)(arow0 + fr) * K + w * kslice + 8 * fq;
    const bf16_t* bp = Bt + (size_t)fr * K + w * kslice + 8 * fq;
    f32x4 acc[4][4];
#pragma unroll
    for (int mi = 0; mi < 4; ++mi)
#pragma unroll
        for (int ni = 0; ni < 4; ++ni) acc[mi][ni] = (f32x4){0.f, 0.f, 0.f, 0.f};
    int s = 0;
    for (; s + 4 <= steps; s += 4) cg_chunk<4>(acc, ap + s * 32, bp + s * 32, brow, K);
    if (steps - s == 3) cg_chunk<3>(acc, ap + s * 32, bp + s * 32, brow, K);
    else if (steps - s == 2) cg_chunk<2>(acc, ap + s * 32, bp + s * 32, brow, K);
    else if (steps - s == 1) cg_chunk<1>(acc, ap + s * 32, bp + s * 32, brow, K);
#pragma unroll
    for (int mi = 0; mi < 4; ++mi)
#pragma unroll
        for (int ni = 0; ni < 4; ++ni) *(LAS f32x4*)(part + (w * 64 + 16 * mi + fr) * 64 + ((16 * ni + 4 * fq) ^ (fr << 2))) = acc[mi][ni];
    __syncthreads();
    { const int row = F.tid >> 3, c8 = (F.tid & 7) * 8, sw = (row & 15) << 2;
      if (MODE == 0) {
          f32x4 s0 = (f32x4){0.f, 0.f, 0.f, 0.f}, s1 = s0;
#pragma unroll
          for (int ww = 0; ww < 8; ++ww) { s0 += *(const LAS f32x4*)(part + (ww * 64 + row) * 64 + (c8 ^ sw)); s1 += *(const LAS f32x4*)(part + (ww * 64 + row) * 64 + ((c8 + 4) ^ sw)); }
          u32x4 o; o.x = pk2(s0[0], s0[1]); o.y = pk2(s0[2], s0[3]); o.z = pk2(s1[0], s1[1]); o.w = pk2(s1[2], s1[3]);
          *(u32x4*)(O + (size_t)(arow0 + row) * ldc + cb * 64 + c8) = o;
      } else if (c8 < 32) {
          f32x4 g0 = (f32x4){0.f, 0.f, 0.f, 0.f}, g1 = g0, u0 = g0, u1 = g0;
#pragma unroll
          for (int ww = 0; ww < 8; ++ww) { const LAS float* pr = part + (ww * 64 + row) * 64;
              g0 += *(const LAS f32x4*)(pr + (c8 ^ sw)); g1 += *(const LAS f32x4*)(pr + ((c8 + 4) ^ sw)); u0 += *(const LAS f32x4*)(pr + ((c8 + 32) ^ sw)); u1 += *(const LAS f32x4*)(pr + ((c8 + 36) ^ sw)); }
          float o[8];
#pragma unroll
          for (int j = 0; j < 4; ++j) { o[j] = fsilu(g0[j]) * u0[j]; o[4 + j] = fsilu(g1[j]) * u1[j]; }
          u32x4 ov; ov.x = pk2(o[0], o[1]); ov.y = pk2(o[2], o[3]); ov.z = pk2(o[4], o[5]); ov.w = pk2(o[6], o[7]);
          *(u32x4*)(O + (size_t)(arow0 + row) * ldc + cb * 32 + c8) = ov;
      } }
    __syncthreads();
}

DEV void wt_tile(const Fr& F, const float* src, int src_ld, int ncols_valid, int srccol0, int kt, bf16_t* dst, int K, int p0) {
    LAS float* tile = (LAS float*)F.lds;
    const int t = F.tid;
#pragma unroll
    for (int ps = 0; ps < 2; ++ps) {
        const int kk = (t >> 4) + 32 * ps, c4 = (t & 15) * 4;
        f32x4 v = (f32x4){0.f, 0.f, 0.f, 0.f};
        if (srccol0 + c4 < ncols_valid) v = *(const f32x4*)(src + (size_t)(kt * 64 + kk) * src_ld + srccol0 + c4);
#pragma unroll
        for (int i = 0; i < 4; ++i) tile[kk * 65 + c4 + i] = v[i];
    }
    __syncthreads();
    { const int p = t >> 3, ks = (t & 7) * 8; float o[8];
#pragma unroll
      for (int i = 0; i < 8; ++i) o[i] = tile[(ks + i) * 65 + p];
      u32x4 w; w.x = pk2(o[0], o[1]); w.y = pk2(o[2], o[3]); w.z = pk2(o[4], o[5]); w.w = pk2(o[6], o[7]);
      *(u32x4*)(dst + (size_t)(p0 + p) * K + kt * 64 + ks) = w; }
    __syncthreads();
}

DEV void prologue_a(const Fr& F) {
    constexpr int T_IN = 40 * 16, T_OUT = 16 * 16, T_FI = 88 * 16, T_FO = 16 * 44, T_L = T_IN + T_OUT + T_FI + T_FO;
    for (int idx = F.bid; idx < DEPTH * T_L; idx += F.G) {
        const int l = idx / T_L; int rem = idx % T_L;
        if (rem < T_IN) { const int pt = rem / 16, kt = rem % 16; wt_tile(F, F.in[I_WIN] + (size_t)l * D * INC, INC, INC, pt * 64, kt, wt_ptr(F, l, 0), D, pt * 64); continue; }
        rem -= T_IN;
        if (rem < T_OUT) { const int pt = rem / 16, kt = rem % 16; wt_tile(F, F.in[I_WOUT] + (size_t)l * D * D, D, D, pt * 64, kt, wt_ptr(F, l, 1), D, pt * 64); continue; }
        rem -= T_OUT;
        if (rem < T_FI) { const int pt = rem / 16, kt = rem % 16; const int p0 = pt * 64, unit = p0 >> 8, within = p0 & 255;
            const int sc0 = within < 128 ? unit * 128 + within : FH + unit * 128 + within - 128;
            wt_tile(F, F.in[I_WFI] + (size_t)l * D * 2 * FH, 2 * FH, 2 * FH, sc0, kt, wt_ptr(F, l, 2), D, p0); continue; }
        rem -= T_FI;
        { const int pt = rem / 44, kt = rem % 44; wt_tile(F, F.in[I_WFO] + (size_t)l * FH * D, D, D, pt * 64, kt, wt_ptr(F, l, 3), FH, pt * 64); }
    }
    {
        LAS float* sv = (LAS float*)F.lds;
        LAS float* red = sv + 3 * 1024;
        for (int i = F.tid; i < 3 * 1024; i += NTHR) { const int v = i >> 10, k = i & 1023; const float c = v < 2 ? F.in[I_C][v * 1024 + k] : F.in[I_CCTX][k]; sv[i] = fsilu(c); }
        __syncthreads();
        for (int idx = F.bid; idx < DEPTH * 96; idx += F.G) {
            const int l = idx / 96, cg_ = idx % 96; const int col = cg_ * 64 + F.lane, ks = F.wave;
            const float* wp = F.in[I_WMOD] + (size_t)l * D * 6144 + (size_t)(ks * 128) * 6144 + col;
            float a0 = 0.f, a1 = 0.f, a2 = 0.f;
#pragma unroll 8
            for (int k = 0; k < 128; ++k) { const float w = wp[(size_t)k * 6144]; const int kk = ks * 128 + k; a0 += sv[kk] * w; a1 += sv[1024 + kk] * w; a2 += sv[2048 + kk] * w; }
            red[(ks * 3 + 0) * 64 + F.lane] = a0; red[(ks * 3 + 1) * 64 + F.lane] = a1; red[(ks * 3 + 2) * 64 + F.lane] = a2;
            __syncthreads();
            if (F.tid < 192) { const int v = F.tid >> 6, cc = F.tid & 63; float s = 0.f;
#pragma unroll
                for (int w = 0; w < 8; ++w) s += red[(w * 3 + v) * 64 + cc];
                const int c2 = cg_ * 64 + cc; F.MOD[((size_t)l * 3 + v) * 6144 + c2] = s + F.in[I_BMOD][l * 6144 + c2]; }
            __syncthreads();
        }
    }
    for (int i = F.bid * NTHR + F.tid; i < 256 * 16; i += F.G * NTHR) {
        const int pos = i >> 4, fi = i & 15; const float inv = powf(10000.f, -(float)fi * 2.0f / 32.0f); const float ang = (float)pos * inv;
        float s, c; sincosf(ang, &s, &c); F.ROPE[2 * i] = c; F.ROPE[2 * i + 1] = s;
    }
}

struct RowPass { const bf16_t* Y; const float* xs_lat; const float* xs_ctx; bool out_f32; const float* gate; const float* gy; const float* gn; const float* sh; const float* sc; bool writeA; bool skip_ctx; };
template <bool SRCF32>
DEV void rowpass(const Fr& F, const RowPass& P) {
    const int gw = F.bid * 8 + F.wave, nw = F.G * 8;
    const int rb = (int)(((long)gw * MROWS) / nw), re = (int)(((long)(gw + 1) * MROWS) / nw);
    const int c0 = F.lane * 4;
    int curv = -1;
    f32x4 gg[4], gs[4], shv[4];
#pragma unroll
    for (int q = 0; q < 4; ++q) { gg[q] = (f32x4){0.f, 0.f, 0.f, 0.f}; gs[q] = gg[q]; shv[q] = gg[q]; }
    f32x4 xc[4], xn[4], xl[4]; u32x2 yc[4], yn[4], yl[4], bc[4], bn[4], bl[4];
#define RP_LOAD(r_, x_, y_, b_x) do { \
        if (SRCF32) { const int b_ = (r_) / RPB, p_ = (r_) % RPB; const bool ic_ = p_ < CTXL; \
            const float* sp_ = ic_ ? P.xs_ctx + (size_t)(b_ * CTXL + p_) * D : P.xs_lat + (size_t)(b_ * SEQ + p_ - CTXL) * D; \
            _Pragma("unroll") for (int q = 0; q < 4; ++q) x_[q] = *(const f32x4*)(sp_ + q * 256 + c0); } \
        else { _Pragma("unroll") for (int q = 0; q < 4; ++q) b_x[q] = *(const u32x2*)(F.XB + (size_t)(r_) * D + q * 256 + c0); } \
        if (P.Y) { _Pragma("unroll") for (int q = 0; q < 4; ++q) y_[q] = *(const u32x2*)(P.Y + (size_t)(r_) * D + q * 256 + c0); } } while (0)
#pragma unroll
    for (int q = 0; q < 4; ++q) { yc[q] = (u32x2){0u, 0u}; yn[q] = yc[q]; yl[q] = yc[q]; bc[q] = yc[q]; bn[q] = yc[q]; bl[q] = yc[q]; xc[q] = (f32x4){0.f, 0.f, 0.f, 0.f}; xn[q] = xc[q]; xl[q] = xc[q]; }
    if (rb < re) RP_LOAD(rb, xc, yc, bc);
    if (rb + 1 < re) RP_LOAD(rb + 1, xn, yn, bn);
    for (int r = rb; r < re; ++r) {
        if (r + 2 < re) RP_LOAD(r + 2, xl, yl, bl);
        const int b = r / RPB, p = r % RPB; const bool isctx = p < CTXL; const int v = isctx ? 2 : b;
        if (!(isctx && P.skip_ctx)) {
            if (v != curv) { curv = v;
#pragma unroll
                for (int q = 0; q < 4; ++q) { const int col = q * 256 + c0;
                    if (P.Y) { const f32x4 g = *(const f32x4*)(P.gate + v * 6144 + col), gy = *(const f32x4*)(P.gy + col); gg[q] = g * gy; }
                    if (P.writeA) { const f32x4 gn = *(const f32x4*)(P.gn + col), sc = *(const f32x4*)(P.sc + v * 6144 + col); gs[q] = gn * (sc + 1.f); shv[q] = *(const f32x4*)(P.sh + v * 6144 + col); } } }
            f32x4 x[4];
#pragma unroll
            for (int q = 0; q < 4; ++q) { if (SRCF32) x[q] = xc[q]; else { float f[4]; unpack4(bc[q], f); x[q] = (f32x4){f[0], f[1], f[2], f[3]}; } }
            if (P.Y) {
                float y[16]; float ss = 0.f;
#pragma unroll
                for (int q = 0; q < 4; ++q) unpack4(yc[q], y + 4 * q);
#pragma unroll
                for (int i = 0; i < 16; ++i) ss += y[i] * y[i];
                ss = wave_sum(ss); const float rstd = rsqrtf(ss * (1.f / D) + EPS);
#pragma unroll
                for (int q = 0; q < 4; ++q) {
#pragma unroll
                    for (int jj = 0; jj < 4; ++jj) x[q][jj] += gg[q][jj] * (y[4 * q + jj] * rstd); }
                if (P.out_f32) { float* dst = F.out + (size_t)(b * SEQ + p - CTXL) * D;
#pragma unroll
                    for (int q = 0; q < 4; ++q) *(f32x4*)(dst + q * 256 + c0) = x[q]; }
                else {
#pragma unroll
                    for (int q = 0; q < 4; ++q) { u32x2 w; w.x = pk2(x[q][0], x[q][1]); w.y = pk2(x[q][2], x[q][3]); *(u32x2*)(F.XB + (size_t)r * D + q * 256 + c0) = w;
                        float f[4]; unpack4(w, f); x[q] = (f32x4){f[0], f[1], f[2], f[3]}; } }
            }
            if (P.writeA) {
                float ss = 0.f;
#pragma unroll
                for (int q = 0; q < 4; ++q)
#pragma unroll
                    for (int jj = 0; jj < 4; ++jj) ss += x[q][jj] * x[q][jj];
                ss = wave_sum(ss); const float rstd = rsqrtf(ss * (1.f / D) + EPS);
#pragma unroll
                for (int q = 0; q < 4; ++q) { float o[4];
#pragma unroll
                    for (int jj = 0; jj < 4; ++jj) o[jj] = x[q][jj] * rstd * gs[q][jj] + shv[q][jj];
                    u32x2 w; w.x = pk2(o[0], o[1]); w.y = pk2(o[2], o[3]); *(u32x2*)(F.A + (size_t)r * D + q * 256 + c0) = w; }
            }
        }
#pragma unroll
        for (int q = 0; q < 4; ++q) { xc[q] = xn[q]; yc[q] = yn[q]; xn[q] = xl[q]; yn[q] = yl[q]; bc[q] = bn[q]; bn[q] = bl[q]; }
    }
#undef RP_LOAD
}

struct SguPre { u32x4 v0, v1; u32x2 up[4]; float bias; };
DEV void sgu_prefetch(const Fr& F, int l, int it, SguPre& P) {
    const int b = it / 520, ch = (it >> 2) % NCH, h = it & 3; const int row0 = b * RPB + ch * 128;
    const int tid = F.tid, w = F.wave, fr = F.lane & 15, fq = F.lane >> 4;
    const int t = tid >> 2, part = tid & 3; const bf16_t* zp = F.Z + (size_t)(row0 + t) * ZS + ZC_SGU + 256 + h * 64 + part * 16;
    P.v0 = *(const u32x4*)zp; P.v1 = *(const u32x4*)(zp + 8);
#pragma unroll
    for (int nt = 0; nt < 4; ++nt) P.up[nt] = *(const u32x2*)(F.Z + (size_t)(row0 + 16 * w + fr) * ZS + ZC_SGU + h * 64 + 16 * nt + 4 * fq);
    P.bias = F.in[I_SGUB][(l * 4 + h) * 128 + 16 * w + fr];
}
DEV void sgu_phase(const Fr& F, int l, int it0) {
    LAS bf16_t* Ws = (LAS bf16_t*)F.lds;
    LAS bf16_t* Vh = Ws + 128 * 136;
    const int tid = F.tid, w = F.wave, fr = F.lane & 15, fq = F.lane >> 4;
    int it = it0; while (it < 1040 && (l + 1 == DEPTH && (it >> 2) % NCH < 2)) it += F.G;
    if (it >= 1040) return;
    int h = -1;
    SguPre P; sgu_prefetch(F, l, it, P);
    while (it < 1040) {
        if ((it & 3) != h) { h = it & 3; const float* W = F.in[I_SGUW] + (size_t)(l * 4 + h) * 128 * 128;
#pragma unroll
          for (int i = 0; i < 8; ++i) { const int idx = tid + NTHR * i; const int t = idx >> 5, s4 = (idx & 31) * 4; const f32x4 v = *(const f32x4*)(W + idx * 4);
              u32x2 o; o.x = pk2(v[0], v[1]); o.y = pk2(v[2], v[3]); *(LAS u32x2*)(Ws + t * 136 + s4) = o; } }
        int nx = it + F.G; while (nx < 1040 && (l + 1 == DEPTH && (nx >> 2) % NCH < 2)) nx += F.G;
        const int b = it / 520, ch = (it >> 2) % NCH; const int row0 = b * RPB + ch * 128;
        { const int t = tid >> 2, part = tid & 3;
          float x[16]; unpack8(P.v0, x); unpack8(P.v1, x + 8);
          float s = 0.f;
#pragma unroll
          for (int i = 0; i < 16; ++i) { x[i] = fgelu(x[i]); s += x[i]; }
          s += __shfl_xor(s, 1); s += __shfl_xor(s, 2); const float mu = s * (1.f / 64.f);
          float q = 0.f;
#pragma unroll
          for (int i = 0; i < 16; ++i) { x[i] -= mu; q += x[i] * x[i]; }
          q += __shfl_xor(q, 1); q += __shfl_xor(q, 2); const float rstd = rsqrtf(q * (1.f / 64.f) + EPS);
#pragma unroll
          for (int i = 0; i < 16; i += 2) *(LAS unsigned*)(Vh + t * 72 + part * 16 + i) = pk2(x[i] * rstd, x[i + 1] * rstd); }
        u32x2 up[4];
#pragma unroll
        for (int nt = 0; nt < 4; ++nt) up[nt] = P.up[nt];
        const float bias = P.bias;
        __syncthreads();
        if (nx < 1040) sgu_prefetch(F, l, nx, P);
        f32x4 acc[4];
#pragma unroll
        for (int nt = 0; nt < 4; ++nt) { acc[nt] = (f32x4){0.f, 0.f, 0.f, 0.f};
#pragma unroll
            for (int k0 = 0; k0 < 128; k0 += 32) { const bf16x8 xf = *(const LAS bf16x8*)(Ws + (16 * w + fr) * 136 + k0 + fq * 8); const bf16x8 yf = tr_frag(Vh, 72, k0, 16 * nt, F.lane);
                acc[nt] = __builtin_amdgcn_mfma_f32_16x16x32_bf16(yf, xf, acc[nt], 0, 0, 0); } }
        { const int t = 16 * w + fr;
#pragma unroll
          for (int nt = 0; nt < 4; ++nt) { const int d0 = 16 * nt + 4 * fq; float u[4]; unpack4(up[nt], u);
              float o[4];
#pragma unroll
              for (int j = 0; j < 4; ++j) o[j] = fgelu(u[j]) * (acc[nt][j] + bias);
              u32x2 wv; wv.x = pk2(o[0], o[1]); wv.y = pk2(o[2], o[3]); *(u32x2*)(F.MIX + (size_t)(row0 + t) * D + h * 64 + d0) = wv; } }
        __syncthreads();
        it = nx;
    }
}

struct PoolPre { u32x4 r[3]; };
DEV void pool_prefetch(const Fr& F, int it, PoolPre& P) {
    const int b = it / 520, ch = (it >> 2) % NCH, g = it & 3; const int tid = F.tid;
    const bool isctx = ch < 2; const int seqlen = isctx ? CTXL : SEQ; const int p0 = isctx ? ch * 128 : (ch - 2) * 128; const int seqrow0 = b * RPB + (isctx ? 0 : CTXL);
#pragma unroll
    for (int i = 0; i < 3; ++i) { const int idx = tid + NTHR * i; const int rr = idx >> 3, c8 = (idx & 7) * 8; const int p = p0 - 8 + rr; P.r[i] = (u32x4){0u, 0u, 0u, 0u};
        if (idx < 144 * 8 && p >= 0 && p < seqlen) P.r[i] = *(const u32x4*)(F.Z + (size_t)(seqrow0 + p) * ZS + ZC_POOL + g * 64 + c8); }
}
DEV void pool_phase(const Fr& F, int l, int it0, int stride) {
    LAS float* Zt = (LAS float*)F.lds;
    LAS bf16_t* Dm = (LAS bf16_t*)(F.lds + 144 * 64 * 4);
    LAS bf16_t* Wp = Dm + 128 * 72;
    const int tid = F.tid, w = F.wave, fr = F.lane & 15, fq = F.lane >> 4;
    int it = it0; while (it < 1040 && (l + 1 == DEPTH && (it >> 2) % NCH < 2)) it += stride;
    if (it >= 1040) return;
    int g = -1;
    PoolPre P; pool_prefetch(F, it, P);
    while (it < 1040) {
        int nx = it + stride; while (nx < 1040 && (l + 1 == DEPTH && (nx >> 2) % NCH < 2)) nx += stride;
        const int b = it / 520, ch = (it >> 2) % NCH;
        if ((it & 3) != g) { g = it & 3;
#pragma unroll
            for (int i = 0; i < 2; ++i) { const int idx = tid + NTHR * i; const int c = idx >> 4, d4 = (idx & 15) * 4; const f32x4 v = *(const f32x4*)(F.in[I_POOLW] + (size_t)(l * 4 + g) * 4096 + idx * 4);
                u32x2 o; o.x = pk2(v[0], v[1]); o.y = pk2(v[2], v[3]); *(LAS u32x2*)(Wp + c * 72 + d4) = o; } }
        const bool isctx = ch < 2; const int seqlen = isctx ? CTXL : SEQ; const int p0 = isctx ? ch * 128 : (ch - 2) * 128; const int row0 = b * RPB + ch * 128;
        const int win = 2 << g, half = win >> 1;
#pragma unroll
        for (int i = 0; i < 3; ++i) { const int idx = tid + NTHR * i; if (idx < 144 * 8) { const int rr = idx >> 3, c8 = (idx & 7) * 8; float x[8]; unpack8(P.r[i], x);
#pragma unroll
            for (int j = 0; j < 8; ++j) Zt[rr * 64 + c8 + j] = x[j]; } }
        __syncthreads();
        if (nx < 1040) pool_prefetch(F, nx, P);
        { const int t = tid >> 2, part = tid & 3; const int p = p0 + t; const int lo = max(p - half, 0), hi = min(p + win - half, seqlen); const float rc = 1.f / (float)(hi - lo);
          float s[16];
#pragma unroll
          for (int j = 0; j < 16; ++j) s[j] = 0.f;
          for (int o = -half; o < half; ++o) {
#pragma unroll
              for (int j = 0; j < 16; ++j) s[j] += Zt[(t + 8 + o) * 64 + part * 16 + j]; }
#pragma unroll
          for (int j = 0; j < 16; j += 2) { const float a0 = s[j] * rc - Zt[(t + 8) * 64 + part * 16 + j], a1 = s[j + 1] * rc - Zt[(t + 8) * 64 + part * 16 + j + 1];
              *(LAS unsigned*)(Dm + t * 72 + part * 16 + j) = pk2(a0, a1); } }
        __syncthreads();
        f32x4 acc[4];
#pragma unroll
        for (int nt = 0; nt < 4; ++nt) { acc[nt] = (f32x4){0.f, 0.f, 0.f, 0.f};
#pragma unroll
            for (int k0 = 0; k0 < 64; k0 += 32) { const bf16x8 xf = *(const LAS bf16x8*)(Dm + (16 * w + fr) * 72 + k0 + fq * 8); const bf16x8 yf = tr_frag(Wp, 72, k0, 16 * nt, F.lane);
                acc[nt] = __builtin_amdgcn_mfma_f32_16x16x32_bf16(yf, xf, acc[nt], 0, 0, 0); } }
        { const int t = 16 * w + fr;
#pragma unroll
          for (int nt = 0; nt < 4; ++nt) { const int d0 = 16 * nt + 4 * fq; const f32x4 ps = *(const f32x4*)(F.in[I_POOLS] + l * 256 + g * 64 + d0);
              u32x2 wv; wv.x = pk2(acc[nt][0] * ps[0], acc[nt][1] * ps[1]); wv.y = pk2(acc[nt][2] * ps[2], acc[nt][3] * ps[3]);
              *(u32x2*)(F.MIX + (size_t)(row0 + t) * D + 768 + g * 64 + d0) = wv; } }
        __syncthreads();
        it = nx;
    }
}

DEV void load_rope8(const Fr& F, const bf16_t* zp, int c8, int n, bool rope, float* o) {
    unpack8(*(const u32x4*)(zp + c8), o);
    if (rope) {
        const bool second = (c8 & 16) != 0; float pr[8]; unpack8(*(const u32x4*)(zp + (second ? c8 - 16 : c8 + 16)), pr);
        const int pos = (c8 >= 32) ? (n & 63) : (n >> 6); const float* tb = F.ROPE + (size_t)(pos * 16 + (c8 & 8)) * 2;
#pragma unroll
        for (int e = 0; e < 8; ++e) { const float c = tb[2 * e], s = tb[2 * e + 1]; o[e] = second ? (o[e] * c + pr[e] * s) : (o[e] * c - pr[e] * s); }
    }
}
DEV bf16x8 pack8(const float* x) { u32x4 o; o.x = pk2(x[0], x[1]); o.y = pk2(x[2], x[3]); o.z = pk2(x[4], x[5]); o.w = pk2(x[6], x[7]); return __builtin_bit_cast(bf16x8, o); }
DEV void attn_item(const Fr& F, int l, int b, int qb, int kvh, bool ctxq) {
    LAS bf16_t* Ks = (LAS bf16_t*)F.lds;
    LAS bf16_t* Vs = Ks + 128 * 72;
    LAS bf16_t* Ps = Vs + 128 * 72;
    const int tid = F.tid, w = F.wave, fr = F.lane & 15, fq = F.lane >> 4;
    const int qrow0 = b * RPB + (ctxq ? qb * 128 : CTXL + qb * 128);
    const int g = w >> 2, rq = w & 3, r0 = rq * 32;
    bf16x8 xq[2][2];
#pragma unroll
    for (int mt = 0; mt < 2; ++mt)
#pragma unroll
        for (int ks = 0; ks < 2; ++ks) { const int t = r0 + 16 * mt + fr; float x[8];
            load_rope8(F, F.Z + (size_t)(qrow0 + t) * ZS + ZC_AQ + (kvh * 2 + g) * 64, 32 * ks + 8 * fq, qb * 128 + t, !ctxq, x);
#pragma unroll
            for (int e = 0; e < 8; ++e) x[e] *= 0.18033688011f;
            xq[mt][ks] = pack8(x); }
    const float sink = F.in[I_SINK][l * 4 + kvh * 2 + g] * 1.44269504089f;
    float mrow[2], lrow[2]; f32x4 O[2][4];
#pragma unroll
    for (int mt = 0; mt < 2; ++mt) { mrow[mt] = sink; lrow[mt] = 1.f;
#pragma unroll
        for (int n = 0; n < 4; ++n) O[mt][n] = (f32x4){0.f, 0.f, 0.f, 0.f}; }
    LAS bf16_t* Pw = Ps + w * 32 * 136;
    const int ktl[5] = {0, 1, 2, 3, 4};
    int kt = 0; const int nkt = ctxq ? 2 : 5;
    u32x4 rk[2], rp[2], rv[2];
    auto tile_ok = [&](int k) { const int kb = qb + k - 3; return k < 2 || (kb >= 0 && kb < SEQ / 128); };
#define ATT_PREFETCH(k) do { const int kb_ = qb + (k) - 3; const int krow0_ = b * RPB + ((k) < 2 ? (k) * 128 : CTXL + kb_ * 128); \
        _Pragma("unroll") for (int i = 0; i < 2; ++i) { const int idx = tid + NTHR * i; const int s_ = idx >> 3, c8 = (idx & 7) * 8; \
            const bf16_t* zp = F.Z + (size_t)(krow0_ + s_) * ZS + ZC_AK + kvh * 64; \
            rk[i] = *(const u32x4*)(zp + c8); rp[i] = *(const u32x4*)(zp + ((c8 & 16) ? c8 - 16 : c8 + 16)); \
            rv[i] = *(const u32x4*)(F.Z + (size_t)(krow0_ + s_) * ZS + ZC_AV + kvh * 64 + c8); } } while (0)
    (void)ktl;
    while (kt < nkt && !tile_ok(kt)) ++kt;
    if (kt < nkt) ATT_PREFETCH(kt);
    while (kt < nkt) {
        const int kb = qb + kt - 3; const bool rope = kt >= 2;
        __syncthreads();
#pragma unroll
        for (int i = 0; i < 2; ++i) { const int idx = tid + NTHR * i; const int s_ = idx >> 3, c8 = (idx & 7) * 8;
            float x[8]; unpack8(rk[i], x);
            if (rope) { float pr[8]; unpack8(rp[i], pr); const bool second = (c8 & 16) != 0; const int n = kb * 128 + s_;
                const int pos = (c8 >= 32) ? (n & 63) : (n >> 6); const float* tb = F.ROPE + (size_t)(pos * 16 + (c8 & 8)) * 2;
#pragma unroll
                for (int e = 0; e < 8; ++e) { const float c = tb[2 * e], sn = tb[2 * e + 1]; x[e] = second ? (x[e] * c + pr[e] * sn) : (x[e] * c - pr[e] * sn); } }
            *(LAS bf16x8*)(Ks + s_ * 72 + c8) = pack8(x);
            *(LAS u32x4*)(Vs + s_ * 72 + c8) = rv[i]; }
        __syncthreads();
        int kn = kt + 1; while (kn < nkt && !tile_ok(kn)) ++kn;
        if (kn < nkt) ATT_PREFETCH(kn);
        const int nlo = (kt == 2) ? 2 * rq : 0, nhi = (kt == 4) ? 2 * rq + 2 : 8;
        f32x4 sc[2][8];
#pragma unroll
        for (int nt = 0; nt < 8; ++nt) { if (nt >= nlo && nt < nhi) {
            const bf16x8 y0 = *(const LAS bf16x8*)(Ks + (nt * 16 + fr) * 72 + 8 * fq), y1 = *(const LAS bf16x8*)(Ks + (nt * 16 + fr) * 72 + 32 + 8 * fq);
#pragma unroll
            for (int mt = 0; mt < 2; ++mt) { f32x4 a = __builtin_amdgcn_mfma_f32_16x16x32_bf16(y0, xq[mt][0], (f32x4){0.f, 0.f, 0.f, 0.f}, 0, 0, 0);
                sc[mt][nt] = __builtin_amdgcn_mfma_f32_16x16x32_bf16(y1, xq[mt][1], a, 0, 0, 0); } }
            else { sc[0][nt] = (f32x4){0.f, 0.f, 0.f, 0.f}; sc[1][nt] = sc[0][nt]; } }
        float scl[2];
#pragma unroll
        for (int mt = 0; mt < 2; ++mt) {
            const int tl = r0 + mt * 16 + fr;
            float mx = -INFINITY;
#pragma unroll
            for (int nt = 0; nt < 8; ++nt) { if (nt >= nlo && nt < nhi) {
                const bool dg = (kt == 2 || kt == 4) && (nt == 2 * rq + mt);
                if (dg) {
#pragma unroll
                    for (int j = 0; j < 4; ++j) { const int si = nt * 16 + 4 * fq + j; const bool ok = (kt == 2) ? (si >= tl) : (si <= tl); sc[mt][nt][j] = ok ? sc[mt][nt][j] : -INFINITY; } }
                else if ((kt == 2 && nt < 2 * rq + mt) || (kt == 4 && nt > 2 * rq + mt)) sc[mt][nt] = (f32x4){-INFINITY, -INFINITY, -INFINITY, -INFINITY};
                mx = fmaxf(fmaxf(mx, fmaxf(sc[mt][nt][0], sc[mt][nt][1])), fmaxf(sc[mt][nt][2], sc[mt][nt][3])); } }
            mx = fmaxf(mx, __shfl_xor(mx, 16)); mx = fmaxf(mx, __shfl_xor(mx, 32));
            const float mn = fmaxf(mrow[mt], mx); scl[mt] = __builtin_amdgcn_exp2f(mrow[mt] - mn);
            float sum = 0.f;
#pragma unroll
            for (int nt = 0; nt < 8; ++nt) { if (nt >= nlo && nt < nhi) { float p[4];
#pragma unroll
                for (int j = 0; j < 4; ++j) { p[j] = __builtin_amdgcn_exp2f(sc[mt][nt][j] - mn); sum += p[j]; }
                u32x2 pw; pw.x = pk2(p[0], p[1]); pw.y = pk2(p[2], p[3]); *(LAS u32x2*)(Pw + (mt * 16 + fr) * 136 + nt * 16 + 4 * fq) = pw; } }
            sum += __shfl_xor(sum, 16); sum += __shfl_xor(sum, 32);
            lrow[mt] = lrow[mt] * scl[mt] + sum; mrow[mt] = mn;
#pragma unroll
            for (int n2 = 0; n2 < 4; ++n2) O[mt][n2] *= scl[mt];
        }
        __builtin_amdgcn_wave_barrier();
        const int clo = nlo >> 1, chi = nhi >> 1;
#pragma unroll
        for (int c = 0; c < 4; ++c) { if (c >= clo && c < chi) {
            const bf16x8 p0 = *(const LAS bf16x8*)(Pw + fr * 136 + 32 * c + 8 * fq), p1 = *(const LAS bf16x8*)(Pw + (16 + fr) * 136 + 32 * c + 8 * fq);
#pragma unroll
            for (int n2 = 0; n2 < 4; ++n2) { const bf16x8 vf = tr_frag(Vs, 72, 32 * c, 16 * n2, F.lane);
                O[0][n2] = __builtin_amdgcn_mfma_f32_16x16x32_bf16(vf, p0, O[0][n2], 0, 0, 0); O[1][n2] = __builtin_amdgcn_mfma_f32_16x16x32_bf16(vf, p1, O[1][n2], 0, 0, 0); } } }
        __builtin_amdgcn_wave_barrier();
        kt = kn;
    }
#undef ATT_PREFETCH
#pragma unroll
    for (int mt = 0; mt < 2; ++mt) { const int t = r0 + mt * 16 + fr; const float rl = 1.f / lrow[mt];
#pragma unroll
        for (int n2 = 0; n2 < 4; ++n2) { u32x2 wv; wv.x = pk2(O[mt][n2][0] * rl, O[mt][n2][1] * rl); wv.y = pk2(O[mt][n2][2] * rl, O[mt][n2][3] * rl);
            *(u32x2*)(F.MIX + (size_t)(qrow0 + t) * D + 512 + (kvh * 2 + g) * 64 + n2 * 16 + 4 * fq) = wv; } }
    __syncthreads();
}

struct GateV { float li0, li1, bc0, bc1; };
struct GateRaw { float li0, li1, lp0, lp1; };
DEV GateRaw ml_gates_load(const Fr& F, int l, int row0, int h, int dir, int lane) {
    const int u0 = 2 * lane, u1 = u0 + 1; const int s0 = dir ? 127 - u0 : u0, s1 = dir ? 127 - u1 : u1;
    const float bi = F.in[I_GATEB][l * 16 + (dir * 2) * 4 + h], bf = F.in[I_GATEB][l * 16 + (dir * 2 + 1) * 4 + h];
    const bf16_t* z0 = F.Z + (size_t)(row0 + s0) * ZS + ZC_MG, * z1 = F.Z + (size_t)(row0 + s1) * ZS + ZC_MG;
    GateRaw r; r.li0 = bf2f(z0[(dir * 2) * 4 + h]) + bi; r.li1 = bf2f(z1[(dir * 2) * 4 + h]) + bi;
    r.lp0 = bf2f(z0[(dir * 2 + 1) * 4 + h]) + bf; r.lp1 = bf2f(z1[(dir * 2 + 1) * 4 + h]) + bf; return r;
}
DEV GateV ml_gates_fin(const GateRaw& g, int lane) {
    GateV r; r.li0 = g.li0; r.li1 = g.li1;
    const float lf0 = logsigmoid(g.lp0), lf1 = logsigmoid(g.lp1);
    const float incl = wave_scan_add(lf0 + lf1, lane);
    r.bc1 = incl; r.bc0 = incl - lf1; return r;
}
DEV void conv_silu8(const Fr& F, int seqrow0, int seqlen, int p, int zc, const float* cw, float scale, float* o) {
    float a[8], x[8];
#pragma unroll
    for (int j = 0; j < 8; ++j) a[j] = 0.f;
#pragma unroll
    for (int tap = 0; tap < 3; ++tap) { const int pp = p + tap - 1; if (pp >= 0 && pp < seqlen) { unpack8(*(const u32x4*)(F.Z + (size_t)(seqrow0 + pp) * ZS + zc), x);
        const f32x4 w0 = *(const f32x4*)(cw + tap * 512), w1 = *(const f32x4*)(cw + tap * 512 + 4);
#pragma unroll
        for (int j = 0; j < 4; ++j) { a[j] += x[j] * w0[j]; a[4 + j] += x[4 + j] * w1[j]; } } }
#pragma unroll
    for (int j = 0; j < 8; ++j) o[j] = fsilu(a[j]) * scale;
}

DEV void ml_local_item(const Fr& F, int l, int b, int ch, int h) {
    LAS bf16_t* Vs = (LAS bf16_t*)F.lds;
    LAS bf16_t* KTf = Vs + 128 * 72;
    LAS bf16_t* KTb = KTf + 128 * 72;
    LAS float* wv = (LAS float*)(KTb + 128 * 72);
    const int tid = F.tid, w = F.wave, lane = F.lane, fr = lane & 15, fq = lane >> 4;
    const bool isctx = ch < 2; const int seqlen = isctx ? CTXL : SEQ; const int p0 = isctx ? ch * 128 : (ch - 2) * 128;
    const int seqrow0 = b * RPB + (isctx ? 0 : CTXL); const int row0 = b * RPB + ch * 128;
    GateRaw graw; graw.li0 = graw.li1 = graw.lp0 = graw.lp1 = 0.f;
    if (w < 2) graw = ml_gates_load(F, l, row0, h, w, lane);
    u32x4 vv[2]; float kk[2][8];
#pragma unroll
    for (int i = 0; i < 2; ++i) { const int idx = tid + NTHR * i; const int s = idx >> 3, c8 = (idx & 7) * 8;
        vv[i] = *(const u32x4*)(F.Z + (size_t)(row0 + s) * ZS + ZC_MV + h * 64 + c8);
        conv_silu8(F, seqrow0, seqlen, p0 + s, ZC_MK + h * 64 + c8, F.in[I_CONVW] + l * 1536 + 256 + h * 64 + c8, 0.125f, kk[i]);
        *(bf16x8*)(F.A + (size_t)(row0 + s) * 256 + h * 64 + c8) = pack8(kk[i]); }
    if (w < 2) { const int dir = w; const GateV gv = ml_gates_fin(graw, lane);
        const float a0 = gv.li0 - gv.bc0, a1 = gv.li1 - gv.bc1; const float A = wave_max(fmaxf(a0, a1));
        const int u0 = 2 * lane; const int s0 = dir ? 127 - u0 : u0, s1 = dir ? 126 - u0 : u0 + 1;
        wv[dir * 128 + s0] = __expf(a0 - A); wv[dir * 128 + s1] = __expf(a1 - A);
        const int chain = dir * 8 + b * 4 + h;
        if (lane == 63) { F.AL[chain * NCH + ch] = A; F.BE[chain * NCH + ch] = gv.bc1; } }
    __syncthreads();
#pragma unroll
    for (int i = 0; i < 2; ++i) { const int idx = tid + NTHR * i; const int s = idx >> 3, c8 = (idx & 7) * 8;
        *(LAS u32x4*)(Vs + s * 72 + c8) = vv[i];
        const float wf = wv[s], wb = wv[128 + s];
        float kf[8], kb[8];
#pragma unroll
        for (int j = 0; j < 8; ++j) { kf[j] = kk[i][j] * wf; kb[j] = kk[i][j] * wb; }
        *(LAS bf16x8*)(KTf + s * 72 + c8) = pack8(kf); *(LAS bf16x8*)(KTb + s * 72 + c8) = pack8(kb); }
    __syncthreads();
    { const int dir = w >> 2, mt = w & 3; const int chain = dir * 8 + b * 4 + h; float* cl = F.CL + ((size_t)chain * NCH + ch) * 4096;
      const LAS bf16_t* KT = dir ? KTb : KTf;
      bf16x8 vfr[4];
#pragma unroll
      for (int c = 0; c < 4; ++c) vfr[c] = tr_frag(Vs, 72, 32 * c, 16 * mt, lane);
#pragma unroll
      for (int nt = 0; nt < 4; ++nt) { f32x4 acc = (f32x4){0.f, 0.f, 0.f, 0.f};
#pragma unroll
          for (int c = 0; c < 4; ++c) acc = __builtin_amdgcn_mfma_f32_16x16x32_bf16(tr_frag(KT, 72, 32 * c, 16 * nt, lane), vfr[c], acc, 0, 0, 0);
          *(f32x4*)(cl + (16 * mt + fr) * 64 + 16 * nt + 4 * fq) = acc; } }
    if (tid < 128) { const int dir = tid >> 6, d = tid & 63; const LAS bf16_t* KT = (dir ? KTb : KTf) + d; float s = 0.f;
        for (int i = 0; i < 128; ++i) s += bf2f(KT[i * 72]);
        const int chain = dir * 8 + b * 4 + h; F.NL[((size_t)chain * NCH + ch) * 64 + d] = s; }
    __syncthreads();
}

DEV int scan_order(int dir, int i) { return dir == 0 ? i : (i == 0 ? 1 : (i == 1 ? 0 : 131 - i)); }
DEV void ml_scan(const Fr& F) {
    const int gidx = F.bid * NTHR + F.tid;
    if (gidx >= 16 * 4160) return;
    const int chain = gidx / 4160, e = gidx % 4160, dir = chain >> 3;
    float* base; int stride;
    if (e < 4096) { base = F.CL + (size_t)chain * NCH * 4096 + e; stride = 4096; } else { base = F.NL + (size_t)chain * NCH * 64 + (e - 4096); stride = 64; }
    const float* al = F.AL + chain * NCH; const float* be = F.BE + chain * NCH; float* ms = F.MS + chain * NCH;
    float st = 0.f, m = 0.f;
    for (int i0 = 0; i0 < NCH; i0 += 26) {
        float v[26], A[26], B[26];
#pragma unroll
        for (int u = 0; u < 26; ++u) { const int cc = scan_order(dir, i0 + u); v[u] = base[(size_t)cc * stride]; A[u] = al[cc]; B[u] = be[cc]; }
#pragma unroll
        for (int u = 0; u < 26; ++u) { const int cc = scan_order(dir, i0 + u); const float Ml = fmaxf(m, A[u]); const float dec = __expf(m - Ml), scl = __expf(A[u] - Ml);
            base[(size_t)cc * stride] = st; if (e == 0) ms[cc] = m;
            st = dec * st + scl * v[u]; m = B[u] + Ml; }
    }
}

typedef float f32x2 __attribute__((ext_vector_type(2)));
DEV f32x2 fsilu2(f32x2 a) { const f32x2 t = a * -1.44269504089f; f32x2 e; e.x = __builtin_amdgcn_exp2f(t.x); e.y = __builtin_amdgcn_exp2f(t.y); const f32x2 d = e + 1.0f;
    f32x2 r; r.x = __builtin_amdgcn_rcpf(d.x); r.y = __builtin_amdgcn_rcpf(d.y); return a * r; }
struct MoPre { u32x4 v[2], k[2], q[2][3]; f32x4 ct[4]; GateRaw g; float mp, nvv; };
DEV void ml_out_prefetch(const Fr& F, int l, int it, MoPre& P) {
    const int b = it / 520, ch = (it >> 2) % NCH, h = it & 3;
    const int tid = F.tid, w = F.wave, lane = F.lane;
    const bool isctx = ch < 2; const int seqlen = isctx ? CTXL : SEQ; const int p0 = isctx ? ch * 128 : (ch - 2) * 128;
    const int seqrow0 = b * RPB + (isctx ? 0 : CTXL); const int row0 = b * RPB + ch * 128;
    P.g.li0 = P.g.li1 = P.g.lp0 = P.g.lp1 = 0.f; P.mp = 0.f;
    if (w < 2) { P.g = ml_gates_load(F, l, row0, h, w, lane); P.mp = F.MS[(w * 8 + b * 4 + h) * NCH + ch]; }
#pragma unroll
    for (int i = 0; i < 2; ++i) { const int idx = tid + NTHR * i; const int s = idx >> 3, c8 = (idx & 7) * 8;
        P.v[i] = *(const u32x4*)(F.Z + (size_t)(row0 + s) * ZS + ZC_MV + h * 64 + c8);
        P.k[i] = *(const u32x4*)(F.A + (size_t)(row0 + s) * 256 + h * 64 + c8);
#pragma unroll
        for (int tap = 0; tap < 3; ++tap) { const int pp = p0 + s + tap - 1; P.q[i][tap] = (u32x4){0u, 0u, 0u, 0u};
            if (pp >= 0 && pp < seqlen) P.q[i][tap] = *(const u32x4*)(F.Z + (size_t)(seqrow0 + pp) * ZS + ZC_MQ + h * 64 + c8); } }
#pragma unroll
    for (int i = 0; i < 4; ++i) { const int idx = tid + NTHR * i; const int dir = idx >> 10, e = (idx >> 4) & 63, d4 = (idx & 15) * 4; const int chain = dir * 8 + b * 4 + h;
        P.ct[i] = *(const f32x4*)(F.CL + ((size_t)chain * NCH + ch) * 4096 + e * 64 + d4); }
    P.nvv = 0.f;
    if (tid < 128) { const int dir = tid >> 6, d = tid & 63; const int chain = dir * 8 + b * 4 + h; P.nvv = F.NL[((size_t)chain * NCH + ch) * 64 + d]; }
}
DEV void ml_out_item(const Fr& F, int l, int it, MoPre& P, int nx) {
    const int b = it / 520, ch = (it >> 2) % NCH, h = it & 3;
    LAS bf16_t* Qs = (LAS bf16_t*)F.lds;
    LAS bf16_t* Ks = Qs + 128 * 72;
    LAS bf16_t* Vs = Ks + 128 * 72;
    LAS bf16_t* CT = Vs + 128 * 72;
    LAS bf16_t* Ps = CT + 2 * 64 * 72;
    LAS float* gvv = (LAS float*)(Ps + 8 * 16 * 136);
    LAS float* nv = gvv + 2 * 4 * 128;
    const int tid = F.tid, w = F.wave, lane = F.lane, fr = lane & 15, fq = lane >> 4;
    const int row0 = b * RPB + ch * 128;
    u32x2 ogp[4]; f32x4 ngp[4];
#pragma unroll
    for (int n2 = 0; n2 < 4; ++n2) { const int e0 = 16 * n2 + 4 * fq; ogp[n2] = *(const u32x2*)(F.Z + (size_t)(row0 + 16 * w + fr) * ZS + ZC_MO + h * 64 + e0); ngp[n2] = *(const f32x4*)(F.in[I_MNORMG] + l * 256 + h * 64 + e0); }
    if (w < 2) { const int dir = w; const GateV gv = ml_gates_fin(P.g, lane); const float mp = P.mp;
        const float a0 = gv.li0 - gv.bc0, a1 = gv.li1 - gv.bc1;
        const float cm = wave_scan_max(fmaxf(a0, a1), lane); const float cmprev = cummax_prev(cm);
        const float M0 = fmaxf(mp, fmaxf(cmprev, a0)), M1 = fmaxf(mp, cm);
        const int u0 = 2 * lane; const int s0 = dir ? 127 - u0 : u0, s1 = dir ? 126 - u0 : u0 + 1;
        LAS float* gb = gvv + dir * 512;
        gb[s0] = a0 * 1.44269504089f; gb[s1] = a1 * 1.44269504089f; gb[128 + s0] = M0 * 1.44269504089f; gb[128 + s1] = M1 * 1.44269504089f; gb[256 + s0] = __expf(mp - M0); gb[256 + s1] = __expf(mp - M1);
        gb[384 + s0] = __expf(-gv.bc0 - M0); gb[384 + s1] = __expf(-gv.bc1 - M1); }
#pragma unroll
    for (int i = 0; i < 2; ++i) { const int idx = tid + NTHR * i; const int s = idx >> 3, c8 = (idx & 7) * 8;
        *(LAS u32x4*)(Vs + s * 72 + c8) = P.v[i];
        *(LAS u32x4*)(Ks + s * 72 + c8) = P.k[i];
        const float* cw = F.in[I_CONVW] + l * 1536 + h * 64 + c8;
        f32x2 a[4]; float x[8];
#pragma unroll
        for (int q = 0; q < 4; ++q) a[q] = (f32x2){0.f, 0.f};
#pragma unroll
        for (int tap = 0; tap < 3; ++tap) { unpack8(P.q[i][tap], x); const f32x4 w0 = *(const f32x4*)(cw + tap * 512), w1 = *(const f32x4*)(cw + tap * 512 + 4);
            a[0] += (f32x2){x[0], x[1]} * (f32x2){w0[0], w0[1]}; a[1] += (f32x2){x[2], x[3]} * (f32x2){w0[2], w0[3]};
            a[2] += (f32x2){x[4], x[5]} * (f32x2){w1[0], w1[1]}; a[3] += (f32x2){x[6], x[7]} * (f32x2){w1[2], w1[3]}; }
        float k[8];
#pragma unroll
        for (int q = 0; q < 4; ++q) { const f32x2 r = fsilu2(a[q]); k[2 * q] = r.x; k[2 * q + 1] = r.y; }
        *(LAS bf16x8*)(Qs + s * 72 + c8) = pack8(k); }
#pragma unroll
    for (int i = 0; i < 4; ++i) { const int idx = tid + NTHR * i; const int dir = idx >> 10, e = (idx >> 4) & 63, d4 = (idx & 15) * 4;
        u32x2 o; o.x = pk2(P.ct[i][0], P.ct[i][1]); o.y = pk2(P.ct[i][2], P.ct[i][3]); *(LAS u32x2*)(CT + (dir * 64 + e) * 72 + d4) = o; }
    if (tid < 128) nv[tid] = P.nvv;
    __syncthreads();
    if (nx >= 0) ml_out_prefetch(F, l, nx, P);
    const int t = 16 * w + fr;
    f32x4 S[8];
#pragma unroll
    for (int nt = 0; nt < 8; ++nt) S[nt] = mma_nt<64>(Qs + 16 * w * 72, 72, Ks + 16 * nt * 72, 72, (f32x4){0.f, 0.f, 0.f, 0.f}, fr, fq);
    float qn0 = 0.f, qn1 = 0.f;
    { float q[16]; unpack8(*(const LAS u32x4*)(Qs + t * 72 + fq * 16), q); unpack8(*(const LAS u32x4*)(Qs + t * 72 + fq * 16 + 8), q + 8);
#pragma unroll
      for (int j = 0; j < 16; ++j) { qn0 += q[j] * nv[fq * 16 + j]; qn1 += q[j] * nv[64 + fq * 16 + j]; }
      qn0 += __shfl_xor(qn0, 16); qn0 += __shfl_xor(qn0, 32); qn1 += __shfl_xor(qn1, 16); qn1 += __shfl_xor(qn1, 32); }
    LAS bf16_t* Pw = Ps + w * 16 * 136;
    f32x4 hs[4];
#pragma unroll
    for (int n2 = 0; n2 < 4; ++n2) hs[n2] = (f32x4){0.f, 0.f, 0.f, 0.f};
#pragma unroll
    for (int dir = 0; dir < 2; ++dir) {
        const LAS float* gb = gvv + dir * 512;
        const float Mt = gb[128 + t], inter = gb[256 + t], em = gb[384 + t];
        float den = 0.f;
#pragma unroll
        for (int nt = 0; nt < 8; ++nt) { const bool full = dir ? (nt > w) : (nt < w); const bool diag = (nt == w);
            if (full || diag) { const f32x4 av = *(const LAS f32x4*)(gb + nt * 16 + 4 * fq); float p[4];
#pragma unroll
                for (int j = 0; j < 4; ++j) p[j] = S[nt][j] * __builtin_amdgcn_exp2f(av[j] - Mt);
                if (diag) {
#pragma unroll
                    for (int j = 0; j < 4; ++j) { const int si = nt * 16 + 4 * fq + j; const bool ok = dir ? (si >= t) : (si <= t); p[j] = ok ? p[j] : 0.f; } }
                den += (p[0] + p[1]) + (p[2] + p[3]);
                u32x2 pw; pw.x = pk2(p[0], p[1]); pw.y = pk2(p[2], p[3]); *(LAS u32x2*)(Pw + fr * 136 + nt * 16 + 4 * fq) = pw; }
            else if (nt == (w ^ 1)) *(LAS u32x2*)(Pw + fr * 136 + nt * 16 + 4 * fq) = (u32x2){0u, 0u}; }
        den += __shfl_xor(den, 16); den += __shfl_xor(den, 32);
        den += inter * (dir ? qn1 : qn0);
        const float rd = 1.f / fmaxf(fabsf(den), em);
        __builtin_amdgcn_wave_barrier();
        f32x4 acc[4];
#pragma unroll
        for (int n2 = 0; n2 < 4; ++n2) { acc[n2] = mma_nt<64>(Qs + 16 * w * 72, 72, CT + (dir * 64 + 16 * n2) * 72, 72, (f32x4){0.f, 0.f, 0.f, 0.f}, fr, fq); acc[n2] *= inter; }
#pragma unroll
        for (int c = 0; c < 4; ++c) { if (dir ? (c >= (w >> 1)) : (c <= (w >> 1))) {
            const bf16x8 pf = *(const LAS bf16x8*)(Pw + fr * 136 + 32 * c + 8 * fq);
#pragma unroll
            for (int n2 = 0; n2 < 4; ++n2) acc[n2] = __builtin_amdgcn_mfma_f32_16x16x32_bf16(tr_frag(Vs, 72, 32 * c, 16 * n2, lane), pf, acc[n2], 0, 0, 0); } }
#pragma unroll
        for (int n2 = 0; n2 < 4; ++n2) hs[n2] += acc[n2] * rd;
        __builtin_amdgcn_wave_barrier();
    }
    { float s = 0.f;
#pragma unroll
      for (int n2 = 0; n2 < 4; ++n2)
#pragma unroll
          for (int j = 0; j < 4; ++j) s += hs[n2][j];
      s += __shfl_xor(s, 16); s += __shfl_xor(s, 32); const float mu = s * (1.f / 64.f);
      float q = 0.f;
#pragma unroll
      for (int n2 = 0; n2 < 4; ++n2)
#pragma unroll
          for (int j = 0; j < 4; ++j) { hs[n2][j] -= mu; q += hs[n2][j] * hs[n2][j]; }
      q += __shfl_xor(q, 16); q += __shfl_xor(q, 32); const float rstd = rsqrtf(q * (1.f / 64.f) + EPS);
#pragma unroll
      for (int n2 = 0; n2 < 4; ++n2) { const int e0 = 16 * n2 + 4 * fq; const f32x4 ng = ngp[n2];
          float og[4]; unpack4(ogp[n2], og);
          float o[4];
#pragma unroll
          for (int j = 0; j < 4; ++j) o[j] = hs[n2][j] * rstd * ng[j] * fsigmoid(og[j]);
          u32x2 wv; wv.x = pk2(o[0], o[1]); wv.y = pk2(o[2], o[3]); *(u32x2*)(F.MIX + (size_t)(row0 + t) * D + 256 + h * 64 + e0) = wv; } }
    __syncthreads();
}


#define XB_TMO      128
#define XB_XCNT(j)  (256  + 64 * (j))
#define XB_XSUB(j)  (1280 + 64 * (j))
#define XB_XGEN(j)  (2304 + 64 * (j))
#define XB_TOP      3328
#define XB_TOPGEN   3392
#define XCD_BAR_WORDS 3456
#define XB_SPIN_CAP (1u << 22)
DEV unsigned xb_ld(unsigned* p)              { return __hip_atomic_load(p, __ATOMIC_RELAXED, __HIP_MEMORY_SCOPE_AGENT); }
DEV unsigned xb_add(unsigned* p, unsigned v) { return __hip_atomic_fetch_add(p, v, __ATOMIC_RELAXED, __HIP_MEMORY_SCOPE_AGENT); }
DEV unsigned xb_xcc_id() { return (unsigned)__builtin_amdgcn_s_getreg((3 << 11) | 20) & 0xFu; }
#define XB_SPIN(cond, bar) do { unsigned _sp = 0; while (cond) { __builtin_amdgcn_s_sleep(1); \
    if ((++_sp & 255u) == 0u) { if (xb_ld(&(bar)[XB_TMO])) break; if (_sp > XB_SPIN_CAP) { atomicAdd(&(bar)[XB_TMO], 1u); break; } } } } while (0)
struct XcdBarrier { unsigned* bar; unsigned x; volatile LAS unsigned* st; };
DEV XcdBarrier xcd_barrier_post(unsigned* bar, volatile LAS unsigned* st) {
    XcdBarrier b; b.bar = bar; b.x = xb_xcc_id(); b.st = st;
    if (threadIdx.x == 0) (void)xb_add(&bar[XB_XCNT(b.x)], 1u);
    return b;
}
DEV void xcd_barrier_complete(unsigned* bar, unsigned x, unsigned& nloc, unsigned& nx) {
    const unsigned G = gridDim.x * gridDim.y * gridDim.z;
    unsigned sum, cnt, mine, sp = 0u;
    for (;;) {
        sum = 0u; cnt = 0u; mine = 0u;
#pragma unroll
        for (unsigned j = 0; j < 16; ++j) { const unsigned c = xb_ld(&bar[XB_XCNT(j)]); sum += c; cnt += (c > 0u) ? 1u : 0u; mine = (j == x) ? c : mine; }
        if (sum == G) break;
        __builtin_amdgcn_s_sleep(1);
        if ((++sp & 255u) == 0u) { if (xb_ld(&bar[XB_TMO])) break; if (sp > XB_SPIN_CAP) { atomicAdd(&bar[XB_TMO], 1u); break; } }
    }
    nloc = mine > 0u ? mine : 1u; nx = cnt > 0u ? cnt : 1u;
}
DEV void xcd_barrier(const XcdBarrier& b) {
    asm volatile("s_waitcnt vmcnt(0)" ::: "memory");
    __syncthreads();
    if (threadIdx.x == 0) {
        unsigned* bar = b.bar;
        __builtin_amdgcn_s_waitcnt(0);
        unsigned nloc = b.st[0], nx = b.st[1];
        if (nloc == 0u) { xcd_barrier_complete(bar, b.x, nloc, nx); b.st[0] = nloc; b.st[1] = nx; }
        const unsigned old = xb_add(&bar[XB_XSUB(b.x)], 1u);
        const unsigned gen = old / nloc;
        if (old + 1u == (gen + 1u) * nloc) {
            __builtin_amdgcn_fence(__ATOMIC_RELEASE, "agent");
            asm volatile("s_waitcnt vmcnt(0)" ::: "memory");
            const unsigned og = xb_add(&bar[XB_TOP], 1u);
            const unsigned tg = og / nx;
            if (og + 1u == (tg + 1u) * nx) xb_add(&bar[XB_TOPGEN], 1u);
            else XB_SPIN(xb_ld(&bar[XB_TOPGEN]) == tg, bar);
            __builtin_amdgcn_fence(__ATOMIC_ACQUIRE, "agent");
            xb_add(&bar[XB_XGEN(b.x)], 1u);
            asm volatile("s_waitcnt vmcnt(0)" ::: "memory");
        } else {
            XB_SPIN(xb_ld(&bar[XB_XGEN(b.x)]) == gen, bar);
            __builtin_amdgcn_fence(__ATOMIC_ACQUIRE, "agent");
            asm volatile("s_waitcnt vmcnt(0)" ::: "memory");
        }
    }
    __syncthreads();
}

#define CG_LOOP(NCB, CALL) do { if (F.G == 256) { const int xcd_ = F.bid & 7; for (int it2 = F.bid >> 3; ; it2 += 32) { const int cb = xcd_ + 8 * (it2 >> 3); if (cb >= (NCB)) break; const int rb = it2 & 7; CALL; } } \
        else { for (int it = F.bid; it < 8 * (NCB); it += F.G) { const int rb = it / (NCB), cb = it % (NCB); CALL; } } } while (0)
#define RETID() do { int t_ = threadIdx.x; asm volatile("" : "+v"(t_)); F.tid = t_; F.lane = t_ & 63; F.wave = __builtin_amdgcn_readfirstlane(t_ >> 6); } while (0)
__global__ void __launch_bounds__(NTHR, 2) fwd_megakernel(Args args) {
    extern __shared__ __attribute__((aligned(16))) unsigned char lds_raw[];
    cg::grid_group grid = cg::this_grid();
    Fr F;
#pragma unroll
    for (int i = 0; i < 19; ++i) F.in[i] = args.in[i];
    F.out = args.out; F.ws = args.ws;
    F.A = (bf16_t*)(F.ws + WS_A); F.Y = (bf16_t*)(F.ws + WS_Z); F.XB = (bf16_t*)(F.ws + WS_Y);     F.Z = (bf16_t*)(F.ws + WS_Z); F.MIX = (bf16_t*)(F.ws + WS_MIX); F.H = (bf16_t*)(F.ws + WS_H);
    F.CL = (float*)(F.ws + WS_CL); F.NL = (float*)(F.ws + WS_NL); F.AL = (float*)(F.ws + WS_SC); F.BE = F.AL + 16 * NCH; F.MS = F.BE + 16 * NCH;
    F.MOD = (float*)(F.ws + WS_MOD); F.CTXR = (float*)(F.ws + WS_CTXR); F.ROPE = (float*)(F.ws + WS_ROPE);
    F.lds = (LAS unsigned char*)lds_raw;
    RETID(); F.G = gridDim.x; F.bid = blockIdx.x;
    volatile LAS unsigned* xst = (volatile LAS unsigned*)(F.lds + 131072);
    if (F.tid < 4) xst[F.tid] = 0u;
    __syncthreads();
    const XcdBarrier xbar = xcd_barrier_post((unsigned*)(F.ws + WS_BAR), xst);

    prologue_a(F);
    grid.sync(); RETID();
    { RowPass P{nullptr, F.in[I_X], F.in[I_CTX], false, nullptr, nullptr, F.in[I_NORMG], F.MOD, F.MOD + 1024, true, false}; rowpass<true>(F, P); }
    xcd_barrier(xbar); RETID();

    for (int l = 0; l < DEPTH; ++l) {
        const float* MODl = F.MOD + (size_t)l * 3 * 6144; const float* ng = F.in[I_NORMG] + l * 4 * D;
        { pg8::Gemm g{F.A, wt_ptr(F, l, 0), NB * SEQ, ZS, D}; pg8::StaticOrder S; S.init(NB * SEQ, ZS, F.G, F.bid); pg8::EpiBf16 E{F.Z, ZS}; pg8::gemm_phase(F.lds, F.tid, g, S, E); }
        RETID();
        CG_LOOP(37, cgemm_tile<0>(F, F.A, wt_ptr(F, l, 0), D, rb, cb, F.Z, ZS));
        xcd_barrier(xbar); RETID();
        for (int it = F.bid; it < 1040; it += F.G) ml_local_item(F, l, it / 520, (it >> 2) % NCH, it & 3);
        RETID();
        sgu_phase(F, l, (F.bid + 16 * F.G - 1040) % F.G);
        RETID();
        for (int it = (F.bid + 16 * F.G - 2080) % F.G; it < 8; it += F.G) { if (l + 1 == DEPTH) continue; attn_item(F, l, it >> 2, (it >> 1) & 1, it & 1, true); }
        xcd_barrier(xbar); RETID();
        ml_scan(F);
        RETID();
        { unsigned* qctr = (unsigned*)(F.ws + WS_BAR) + XCD_BAR_WORDS + 16 * l; volatile LAS unsigned* qs = (volatile LAS unsigned*)(F.lds + 131072 + 64);
          for (;;) { __syncthreads(); if (F.tid == 0) qs[0] = atomicAdd(qctr, 1u); __syncthreads(); const int it = (int)qs[0]; if (it >= 512) break;
              attn_item(F, l, it >> 8, (it >> 1) & 127, it & 1, false); } }
        xcd_barrier(xbar); RETID();
        { int it = F.bid; while (it < 1040 && (l + 1 == DEPTH && (it >> 2) % NCH < 2)) it += F.G;
          if (it < 1040) { MoPre P; ml_out_prefetch(F, l, it, P);
              while (it < 1040) { int nx = it + F.G; while (nx < 1040 && (l + 1 == DEPTH && (nx >> 2) % NCH < 2)) nx += F.G;
                  ml_out_item(F, l, it, P, nx < 1040 ? nx : -1); it = nx; } } }
        RETID();
        if (F.bid >= 16) pool_phase(F, l, F.bid - 16, F.G - 16);
        xcd_barrier(xbar); RETID();
        { pg8::Gemm g{F.MIX, wt_ptr(F, l, 1), NB * SEQ, D, D}; pg8::StaticOrder S; S.init(NB * SEQ, D, F.G, F.bid); pg8::EpiBf16 E{F.Y, D}; pg8::gemm_phase(F.lds, F.tid, g, S, E); }
        RETID();
        if (l + 1 < DEPTH) CG_LOOP(16, cgemm_tile<0>(F, F.MIX, wt_ptr(F, l, 1), D, rb, cb, F.Y, D));
        xcd_barrier(xbar); RETID();
        { RowPass P{F.Y, F.in[I_X], F.in[I_CTX], false, MODl + 2048, ng + D, ng + 2 * D, MODl + 3072, MODl + 4096, true, l + 1 == DEPTH}; if (l == 0) rowpass<true>(F, P); else rowpass<false>(F, P); }
        xcd_barrier(xbar); RETID();
        { pg8::Gemm g{F.A, wt_ptr(F, l, 2), NB * SEQ, 2 * FH, D}; pg8::StaticOrder S; S.init(NB * SEQ, 2 * FH, F.G, F.bid); pg8::EpiSwiglu E{F.H}; pg8::gemm_phase(F.lds, F.tid, g, S, E); }
        RETID();
        if (l + 1 < DEPTH) CG_LOOP(88, cgemm_tile<1>(F, F.A, wt_ptr(F, l, 2), D, rb, cb, F.H, FH));
        xcd_barrier(xbar); RETID();
        { pg8::Gemm g{F.H, wt_ptr(F, l, 3), NB * SEQ, D, FH}; pg8::StaticOrder S; S.init(NB * SEQ, D, F.G, F.bid); pg8::EpiBf16 E{F.A, D}; pg8::gemm_phase(F.lds, F.tid, g, S, E); }
        RETID();
        if (l + 1 < DEPTH) CG_LOOP(16, cgemm_tile<0>(F, F.H, wt_ptr(F, l, 3), FH, rb, cb, F.A, D));
        xcd_barrier(xbar); RETID();
        { const bool lastl = (l == DEPTH - 1); const float* MODn = MODl + (lastl ? 0 : 3 * 6144); const float* ngn = ng + (lastl ? 0 : 4 * D);
          RowPass P{F.A, nullptr, nullptr, lastl, MODl + 5120, ng + 3 * D, ngn, MODn, MODn + 1024, !lastl, lastl}; rowpass<false>(F, P); }
        if (l + 1 < DEPTH) xcd_barrier(xbar); RETID();
    }
}

extern "C" void kernel_launch(void* const* d_in, const int* in_sizes, int n_in, void* d_out, int out_size, void* d_ws, size_t ws_size, hipStream_t stream) {
    static int grid = 0;
    if (grid == 0) {
        if (n_in != 19 || ws_size < WS_END) { fprintf(stderr, "kernel_launch: need 19 inputs and >= %zu bytes of workspace (got %d, %zu)\n", (size_t)WS_END, n_in, ws_size); grid = -1; return; }
        int dev = 0, cus = 0, per_cu = 0;
        hipGetDevice(&dev); hipDeviceGetAttribute(&cus, hipDeviceAttributeMultiprocessorCount, dev);
        if (hipFuncSetAttribute((const void*)fwd_megakernel, hipFuncAttributeMaxDynamicSharedMemorySize, LDS_BYTES) != hipSuccess) { fprintf(stderr, "kernel_launch: hipFuncSetAttribute failed\n"); grid = -1; return; }
        if (hipOccupancyMaxActiveBlocksPerMultiprocessor(&per_cu, (const void*)fwd_megakernel, NTHR, LDS_BYTES) != hipSuccess || per_cu < 1) { fprintf(stderr, "kernel_launch: occupancy query gives %d\n", per_cu); per_cu = 1; }
        (void)hipGetLastError();
        grid = cus;
    }
    if (grid < 0) return;
    if (hipMemsetAsync((char*)d_ws + WS_BAR, 0, 16384, stream) != hipSuccess) { fprintf(stderr, "kernel_launch: memset failed\n"); return; }
    Args a{};
    for (int i = 0; i < 19; ++i) a.in[i] = (const float*)d_in[i];
    a.out = (float*)d_out; a.ws = (unsigned char*)d_ws;
    void* kargs[] = {&a};
    hipError_t e = hipLaunchCooperativeKernel((const void*)fwd_megakernel, dim3(grid), dim3(NTHR), kargs, LDS_BYTES, stream);
    if (e != hipSuccess) fprintf(stderr, "cooperative launch failed: %s (grid %d)\n", hipGetErrorString(e), grid);
}
```

```cpp
#include <hip/hip_runtime.h>
#include <hip/hip_cooperative_groups.h>
#include <cstdio>
namespace cg = cooperative_groups;

#define LAS __attribute__((address_space(3)))
#define DEV __device__ __forceinline__
typedef unsigned short bf16_t;
typedef short bf16x8 __attribute__((ext_vector_type(8)));
typedef float f32x4 __attribute__((ext_vector_type(4)));
typedef unsigned u32x4 __attribute__((ext_vector_type(4)));
typedef unsigned u32x2 __attribute__((ext_vector_type(2)));

constexpr int D = 1024, NB = 2, SEQ = 16384, CTXL = 256, DEPTH = 4;
constexpr int RPB = SEQ + CTXL;
constexpr int MROWS = NB * RPB;
constexpr int NCH = RPB / 128;
constexpr int ZS = 2560;
constexpr int INC = 2320;
constexpr int FH = 2816;
constexpr int ZC_SGU = 0, ZC_MQ = 512, ZC_MK = 768, ZC_MV = 1024, ZC_MO = 1280, ZC_MG = 1536;
constexpr int ZC_AQ = 1552, ZC_AK = 1808, ZC_AV = 1936, ZC_POOL = 2064;
constexpr float EPS = 1e-6f;

constexpr size_t WS_A = 0;
constexpr size_t SZ_ACT = (size_t)MROWS * D * 2;
constexpr size_t WS_Y = WS_A + SZ_ACT;
constexpr size_t WS_Z = WS_Y + SZ_ACT;
constexpr size_t WS_MIX = WS_Z + (size_t)MROWS * ZS * 2;
constexpr size_t WS_H = WS_Z;
constexpr size_t WS_W = WS_MIX + SZ_ACT;
constexpr size_t SZ_WIN = (size_t)ZS * D * 2, SZ_WOUT = (size_t)D * D * 2, SZ_WFI = (size_t)2 * FH * D * 2, SZ_WFO = (size_t)D * FH * 2;
constexpr size_t SZ_WL = SZ_WIN + SZ_WOUT + SZ_WFI + SZ_WFO;
constexpr size_t WS_CL = WS_W + DEPTH * SZ_WL;
constexpr size_t WS_NL = WS_CL + (size_t)16 * NCH * 4096 * 4;
constexpr size_t WS_SC = WS_NL + (size_t)16 * NCH * 64 * 4;
constexpr size_t WS_MOD = WS_SC + 32768;
constexpr size_t WS_CTXR = WS_MOD + (size_t)DEPTH * 3 * 6144 * 4;
constexpr size_t WS_ROPE = WS_CTXR + (size_t)NB * CTXL * D * 4;
constexpr size_t WS_BAR = WS_ROPE + 40960;
constexpr size_t WS_END = WS_BAR + 16384;
static_assert(WS_H + (size_t)MROWS * FH * 2 <= WS_W, "H alias");

constexpr int NTHR = 512;
constexpr int LDS_BYTES = 135168;

DEV unsigned f2bf(float f) { unsigned u = __builtin_bit_cast(unsigned, f); return (u + 0x7fffu + ((u >> 16) & 1u)) >> 16; }
DEV unsigned pk2(float lo, float hi) { unsigned r; asm("v_cvt_pk_bf16_f32 %0, %1, %2" : "=v"(r) : "v"(lo), "v"(hi)); return r; }
DEV float bf2f(unsigned v) { return __builtin_bit_cast(float, v << 16); }
DEV void unpack8(u32x4 v, float* o) {
#pragma unroll
    for (int i = 0; i < 4; ++i) { o[2 * i] = bf2f(v[i] & 0xffffu); o[2 * i + 1] = __builtin_bit_cast(float, v[i] & 0xffff0000u); }
}
DEV void unpack4(u32x2 v, float* o) {
#pragma unroll
    for (int i = 0; i < 2; ++i) { o[2 * i] = bf2f(v[i] & 0xffffu); o[2 * i + 1] = __builtin_bit_cast(float, v[i] & 0xffff0000u); }
}
DEV float fsigmoid(float x) { return __builtin_amdgcn_rcpf(1.f + __expf(-x)); }
DEV float fsilu(float x) { return x * fsigmoid(x); }
DEV float fgelu(float x) { const float y = 0.7978845608f * (x + 0.044715f * x * x * x); const float t = 1.f - 2.f * __builtin_amdgcn_rcpf(__expf(2.f * y) + 1.f); return 0.5f * x * (1.f + t); }
DEV float logsigmoid(float x) { return fminf(x, 0.f) - log1pf(__expf(-fabsf(x))); }
#define DPPF(idbits, v, ctrl, rmask) __builtin_bit_cast(float, __builtin_amdgcn_update_dpp((int)(idbits), __builtin_bit_cast(int, (v)), (ctrl), (rmask), 0xf, false))
DEV float red4_add(float v) { v += __shfl_xor(v, 16); v += __shfl_xor(v, 32); return v; }
DEV float red4_max(float v) { v = fmaxf(v, __shfl_xor(v, 16)); v = fmaxf(v, __shfl_xor(v, 32)); return v; }
DEV float wave_sum(float v) {
    v += DPPF(0, v, 0x128, 0xf); v += DPPF(0, v, 0x124, 0xf); v += DPPF(0, v, 0x122, 0xf); v += DPPF(0, v, 0x121, 0xf);
    return red4_add(v);
}
DEV float wave_max(float v) {
    v = fmaxf(v, DPPF(0xff800000u, v, 0x128, 0xf)); v = fmaxf(v, DPPF(0xff800000u, v, 0x124, 0xf)); v = fmaxf(v, DPPF(0xff800000u, v, 0x122, 0xf)); v = fmaxf(v, DPPF(0xff800000u, v, 0x121, 0xf));
    return red4_max(v);
}
DEV float wave_scan_add(float v, int lane) {
    (void)lane;
    v += DPPF(0, v, 0x111, 0xf); v += DPPF(0, v, 0x112, 0xf); v += DPPF(0, v, 0x114, 0xf); v += DPPF(0, v, 0x118, 0xf);
    v += DPPF(0, v, 0x142, 0xa); v += DPPF(0, v, 0x143, 0xc);
    return v;
}
DEV float wave_scan_max(float v, int lane) {
    (void)lane;
    v = fmaxf(v, DPPF(0xff800000u, v, 0x111, 0xf)); v = fmaxf(v, DPPF(0xff800000u, v, 0x112, 0xf)); v = fmaxf(v, DPPF(0xff800000u, v, 0x114, 0xf)); v = fmaxf(v, DPPF(0xff800000u, v, 0x118, 0xf));
    v = fmaxf(v, DPPF(0xff800000u, v, 0x142, 0xa)); v = fmaxf(v, DPPF(0xff800000u, v, 0x143, 0xc));
    return v;
}
DEV float cummax_prev(float cm) { return fmaxf(DPPF(0xff800000u, cm, 0x111, 0xf), DPPF(0xff800000u, cm, 0x142, 0xe)); }
typedef short v4s __attribute__((ext_vector_type(4)));
DEV bf16x8 tr_frag(const LAS bf16_t* T, int ld, int k0, int n0, int lane) {
    const int g = lane >> 4, q = (lane & 15) >> 2, p = lane & 3;
    const LAS bf16_t* a0 = T + (k0 + 8 * g + q) * ld + n0 + 4 * p;
    const v4s lo = __builtin_amdgcn_ds_read_tr16_b64_v4i16((LAS v4s*)a0), hi = __builtin_amdgcn_ds_read_tr16_b64_v4i16((LAS v4s*)(a0 + 4 * ld));
    return __builtin_shufflevector(lo, hi, 0, 1, 2, 3, 4, 5, 6, 7);
}
template <int K>
DEV f32x4 mma_nt(const LAS bf16_t* X, int ldx, const LAS bf16_t* Y, int ldy, f32x4 acc, int fr, int fq) {
#pragma unroll
    for (int k0 = 0; k0 < K; k0 += 32) {
        const bf16x8 xf = *(const LAS bf16x8*)(X + fr * ldx + k0 + fq * 8);
        const bf16x8 yf = *(const LAS bf16x8*)(Y + fr * ldy + k0 + fq * 8);
        acc = __builtin_amdgcn_mfma_f32_16x16x32_bf16(yf, xf, acc, 0, 0, 0);
    }
    return acc;
}

namespace pg8 {
constexpr int BM = 256, BK = 64, HALF = 128, HTB = HALF * BK * 2, STAGE_BYTES = 8 * HTB, NXCD = 8, WGM = 8;
DEV int lds_byte(int r, int c) { const int st = (r >> 4) * 2 + (c >> 5), rr = r & 15, cc = c & 31, ob = rr * 64 + cc * 2; return st * 1024 + (ob ^ (((ob >> 9) & 1) << 5)); }
DEV void stage_rc(int b, int& R, int& C) { const int st = b / 1024, sb = b % 1024, swz = sb ^ (((sb >> 9) & 1) << 5); R = (st >> 1) * 16 + swz / 64; C = (st & 1) * 32 + (swz % 64) / 2; }
DEV int perm32(int rho) { const int n = rho >> 4, i = rho & 15; return 8 * (i >> 2) + 4 * n + (i & 3); }
struct Unit { int pm, pn; };
DEV int prow(int pm) { return pm * 256 + 256 + ((pm >> 6) << 8); }
struct Gemm { const bf16_t* A; const bf16_t* Bt; int M, N, K; };
struct StaticOrder {
    int nM, nN, nwg, G, c;
    DEV void init(int M, int N, int G_, int c_) { nM = M / BM; nN = N / BM; nwg = nM * nN; G = G_; c = c_; }
    DEV bool next(int i, Unit& u) const {
        const long L = (long)i * G + c; if (L >= nwg) return false;
        int wgid = (int)L; { const int q = nwg / NXCD, r = nwg % NXCD, xcd = wgid % NXCD, off = wgid / NXCD; wgid = (xcd < r ? xcd * (q + 1) : r * (q + 1) + (xcd - r) * q) + off; }
        const int nig = WGM * nN, gid = wgid / nig, fm = gid * WGM, gsz = (nM - fm) < WGM ? (nM - fm) : WGM;
        u.pm = fm + ((wgid % nig) % gsz); u.pn = (wgid % nig) / gsz; return true;
    }
};
DEV unsigned cvt_pk_bf16(float lo, float hi) { unsigned r; asm volatile("v_cvt_pk_bf16_f32 %0, %1, %2" : "=v"(r) : "v"(lo), "v"(hi)); return r; }
struct EpiBf16 {
    bf16_t* O; int ldc;
    DEV void operator()(const f32x4 (&acc)[2][2][4][2], const Unit& u, int wr, int wc, int fr, int fq) const {
        const int row0 = prow(u.pm) + wr * 64 + fr; const int col0 = u.pn * BM + wc * 32 + 8 * fq;
#pragma unroll
        for (int ai = 0; ai < 2; ++ai)
#pragma unroll
            for (int m = 0; m < 4; ++m) { bf16_t* rowp = O + (size_t)(row0 + ai * HALF + m * 16) * ldc + col0;
#pragma unroll
                for (int bj = 0; bj < 2; ++bj) { const f32x4 v0 = acc[ai][bj][m][0], v1 = acc[ai][bj][m][1];
                    u32x4 w; w.x = cvt_pk_bf16(v0[0], v0[1]); w.y = cvt_pk_bf16(v0[2], v0[3]); w.z = cvt_pk_bf16(v1[0], v1[1]); w.w = cvt_pk_bf16(v1[2], v1[3]);
                    *(u32x4*)(rowp + bj * HALF) = w; } }
    }
};
struct EpiSwiglu {
    bf16_t* O;
    DEV void operator()(const f32x4 (&acc)[2][2][4][2], const Unit& u, int wr, int wc, int fr, int fq) const {
        const int row0 = prow(u.pm) + wr * 64 + fr; const int col0 = u.pn * HALF + wc * 32 + 8 * fq;
#pragma unroll
        for (int ai = 0; ai < 2; ++ai)
#pragma unroll
            for (int m = 0; m < 4; ++m) { bf16_t* rowp = O + (size_t)(row0 + ai * HALF + m * 16) * FH + col0;
                typedef float f32x2 __attribute__((ext_vector_type(2)));
                f32x2 gv[4], uv[4], ev[4], ov[4];
#pragma unroll
                for (int q = 0; q < 4; ++q) { const int n = q >> 1, j = (q & 1) * 2; gv[q] = (f32x2){acc[ai][0][m][n][j], acc[ai][0][m][n][j + 1]}; uv[q] = (f32x2){acc[ai][1][m][n][j], acc[ai][1][m][n][j + 1]}; }
#pragma unroll
                for (int q = 0; q < 4; ++q) { const f32x2 t = gv[q] * -1.44269504089f; ev[q].x = __builtin_amdgcn_exp2f(t.x); ev[q].y = __builtin_amdgcn_exp2f(t.y); }
#pragma unroll
                for (int q = 0; q < 4; ++q) { const f32x2 d = ev[q] + 1.0f; f32x2 r; r.x = __builtin_amdgcn_rcpf(d.x); r.y = __builtin_amdgcn_rcpf(d.y); ov[q] = (gv[q] * r) * uv[q]; }
                float o[8];
#pragma unroll
                for (int q = 0; q < 4; ++q) { o[2 * q] = ov[q].x; o[2 * q + 1] = ov[q].y; }
                u32x4 w; w.x = cvt_pk_bf16(o[0], o[1]); w.y = cvt_pk_bf16(o[2], o[3]); w.z = cvt_pk_bf16(o[4], o[5]); w.w = cvt_pk_bf16(o[6], o[7]);
                *(u32x4*)rowp = w; }
    }
};

template <class Epi>
DEV void gemm_phase(LAS unsigned char* lds, const int tid, const Gemm g, const StaticOrder& S, const Epi& E) {
    const int wid = __builtin_amdgcn_readfirstlane(tid >> 6), lane = tid & 63, wr = wid >> 2, wc = wid & 3, fr = lane & 15, fq = lane >> 4;
    const int K = g.K, nt = K / BK;
    unsigned voffA[2], voffB[2];
#pragma unroll
    for (int i = 0; i < 2; ++i) { int R, C; stage_rc(tid * 16 + i * 8192, R, C); const int Rb = (R & ~31) + perm32(R & 31);
        voffA[i] = (unsigned)(R * K + C) * 2u; voffB[i] = (unsigned)(Rb * K + C) * 2u; }
    const size_t kstep = (size_t)(BK * 2);
    const size_t hstep = (size_t)HALF * K * 2;
    const size_t tstep = 2 * hstep;
    const unsigned ldsw = (unsigned)wid * 1024u;
    const int aoff = lds_byte(wr * 64 + fr, fq * 8), boff = lds_byte(wc * 32 + fr, fq * 8);
#define PG8_SA(b, h) (((b) * 2 + (h)) * HTB)
#define PG8_SB(b, h) ((4 + (b) * 2 + (h)) * HTB)
#define PG8_STAGE(bufoff, gbase, voff) do { _Pragma("unroll") for (int _i = 0; _i < 2; ++_i) \
        __builtin_amdgcn_global_load_lds((const unsigned*)((const char*)(gbase) + (voff)[_i]), (LAS unsigned*)(lds + (bufoff) + ldsw + _i * 8192), 16, 0, 0); } while (0)
#define PG8_LDA(dst, b, h) do { _Pragma("unroll") for (int m = 0; m < 4; ++m) _Pragma("unroll") for (int k = 0; k < 2; ++k) dst[m][k] = *(const LAS bf16x8*)(lds + PG8_SA(b, h) + aoff + m * 2048 + k * 1024); } while (0)
#define PG8_LDB(dst, b, h) do { _Pragma("unroll") for (int n = 0; n < 2; ++n) _Pragma("unroll") for (int k = 0; k < 2; ++k) dst[n][k] = *(const LAS bf16x8*)(lds + PG8_SB(b, h) + boff + n * 2048 + k * 1024); } while (0)
#define PG8_MMA(ai, bj, At, Bt) do { __builtin_amdgcn_s_setprio(1); _Pragma("unroll") for (int m = 0; m < 4; ++m) _Pragma("unroll") for (int n = 0; n < 2; ++n) _Pragma("unroll") for (int k = 0; k < 2; ++k) \
        acc[ai][bj][m][n] = __builtin_amdgcn_mfma_f32_16x16x32_bf16(Bt[n][k], At[m][k], acc[ai][bj][m][n], 0, 0, 0); __builtin_amdgcn_s_setprio(0); } while (0)
#define PG8_WAIT_V(n) asm volatile("s_waitcnt vmcnt(" #n ")" ::: "memory")
#define PG8_WAIT_L(n) asm volatile("s_waitcnt lgkmcnt(" #n ")" ::: "memory")
#define PG8_BAR __builtin_amdgcn_s_barrier()
#define PG8_SCHED __builtin_amdgcn_sched_barrier(0)
    Unit cur, nxt; int ui = 0;
    if (!S.next(0, cur)) return;
    f32x4 acc[2][2][4][2];
#pragma unroll
    for (int a = 0; a < 2; ++a)
#pragma unroll
        for (int b = 0; b < 2; ++b)
#pragma unroll
            for (int m = 0; m < 4; ++m)
#pragma unroll
                for (int n = 0; n < 2; ++n) acc[a][b][m][n] = (f32x4){0.f, 0.f, 0.f, 0.f};
    bf16x8 At[4][2], B0[2][2], B1[2][2];
    const char* cA = (const char*)g.A + (size_t)prow(cur.pm) * K * 2; const char* cB = (const char*)g.Bt + (size_t)cur.pn * tstep;
    PG8_STAGE(PG8_SB(0, 0), cB, voffB); PG8_STAGE(PG8_SA(0, 0), cA, voffA); PG8_STAGE(PG8_SB(0, 1), cB + hstep, voffB); PG8_STAGE(PG8_SA(0, 1), cA + hstep, voffA);
    if (wr == 1) PG8_BAR;
    PG8_WAIT_V(4); PG8_BAR;
    PG8_STAGE(PG8_SB(1, 0), cB + kstep, voffB); PG8_STAGE(PG8_SA(1, 0), cA + kstep, voffA); PG8_STAGE(PG8_SB(1, 1), cB + hstep + kstep, voffB);
    PG8_WAIT_V(6); PG8_BAR;
    for (;;) {
        const bool has_next = S.next(ui + 1, nxt);
        const char* nA = has_next ? (const char*)g.A + (size_t)prow(nxt.pm) * K * 2 : cA; const char* nB = has_next ? (const char*)g.Bt + (size_t)nxt.pn * tstep : cB;
        for (int t = 0; t < nt; t += 2) {
            const bool last = (t == nt - 2);
            const char* a1 = cA + (size_t)(t + 1) * kstep;
            const char* a2 = last ? nA : cA + (size_t)(t + 2) * kstep; const char* b2 = last ? nB : cB + (size_t)(t + 2) * kstep;
            const char* a3 = a2 + kstep; const char* b3 = b2 + kstep;
            PG8_LDB(B0, 0, 0); PG8_SCHED; PG8_LDA(At, 0, 0); PG8_STAGE(PG8_SA(1, 1), a1 + hstep, voffA);
            PG8_WAIT_L(8); PG8_BAR; PG8_WAIT_L(0); PG8_MMA(0, 0, At, B0); PG8_BAR; PG8_SCHED;
            PG8_LDB(B1, 0, 1); PG8_STAGE(PG8_SB(0, 0), b2, voffB);
            PG8_BAR; PG8_WAIT_L(0); PG8_MMA(0, 1, At, B1); PG8_BAR;
            PG8_LDA(At, 0, 1); PG8_STAGE(PG8_SA(0, 0), a2, voffA);
            PG8_BAR; PG8_WAIT_L(0); PG8_MMA(1, 0, At, B0); PG8_BAR; PG8_SCHED;
            PG8_STAGE(PG8_SB(0, 1), b2 + hstep, voffB);
            PG8_WAIT_V(6); PG8_BAR; PG8_MMA(1, 1, At, B1); PG8_BAR;
            PG8_LDB(B0, 1, 0); PG8_SCHED; PG8_LDA(At, 1, 0); PG8_STAGE(PG8_SA(0, 1), a2 + hstep, voffA);
            PG8_WAIT_L(8); PG8_BAR; PG8_WAIT_L(0); PG8_MMA(0, 0, At, B0); PG8_BAR; PG8_SCHED;
            PG8_LDB(B1, 1, 1); PG8_STAGE(PG8_SB(1, 0), b3, voffB);
            PG8_BAR; PG8_WAIT_L(0); PG8_MMA(0, 1, At, B1); PG8_BAR;
            PG8_LDA(At, 1, 1); PG8_STAGE(PG8_SA(1, 0), a3, voffA);
            PG8_BAR; PG8_WAIT_L(0); PG8_MMA(1, 0, At, B0); PG8_BAR; PG8_SCHED;
            PG8_STAGE(PG8_SB(1, 1), b3 + hstep, voffB);
            PG8_WAIT_V(6); PG8_BAR; PG8_MMA(1, 1, At, B1); PG8_BAR;
        }
        E(acc, cur, wr, wc, fr, fq);
        if (!has_next) break;
#pragma unroll
        for (int a = 0; a < 2; ++a)
#pragma unroll
            for (int b = 0; b < 2; ++b)
#pragma unroll
                for (int m = 0; m < 4; ++m)
#pragma unroll
                    for (int n = 0; n < 2; ++n) acc[a][b][m][n] = (f32x4){0.f, 0.f, 0.f, 0.f};
        cur = nxt; cA = nA; cB = nB; ++ui;
    }
    PG8_WAIT_V(0);
    if (wr == 0) PG8_BAR;
    PG8_BAR;
#undef PG8_SA
#undef PG8_SB
#undef PG8_STAGE
#undef PG8_LDA
#undef PG8_LDB
#undef PG8_MMA
#undef PG8_WAIT_V
#undef PG8_WAIT_L
#undef PG8_BAR
#undef PG8_SCHED
}
}

struct Args { const float* in[19]; float* out; unsigned char* ws; };
struct Fr {
    const float* in[19]; float* out; unsigned char* ws;
    bf16_t *A, *Y, *Z, *MIX, *H, *XB; float *CL, *NL, *AL, *BE, *MS, *MOD, *CTXR; float* ROPE;
    LAS unsigned char* lds;
    int tid, lane, wave, G, bid;
};
enum { I_X = 0, I_C, I_CTX, I_CCTX, I_WMOD, I_BMOD, I_NORMG, I_WIN, I_WOUT, I_SGUW, I_SGUB, I_CONVW, I_GATEB, I_MNORMG, I_SINK, I_POOLW, I_POOLS, I_WFI, I_WFO };

DEV bf16_t* wt_ptr(const Fr& F, int l, int which) {
    size_t off = WS_W + (size_t)l * SZ_WL;
    if (which >= 1) off += SZ_WIN; if (which >= 2) off += SZ_WOUT; if (which >= 3) off += SZ_WFI;
    return (bf16_t*)(F.ws + off);
}


template <int CH>
DEV void cg_chunk(f32x4 (&acc)[4][4], const bf16_t* ap, const bf16_t* bp, const int (&brow)[4], int K) {
    bf16x8 a[CH][4], b[CH][4];
#pragma unroll
    for (int c = 0; c < CH; ++c)
#pragma unroll
        for (int i = 0; i < 4; ++i) { a[c][i] = *(const bf16x8*)(ap + (size_t)(16 * i) * K + 32 * c); b[c][i] = *(const bf16x8*)(bp + (size_t)brow[i] * K + 32 * c); }
#pragma unroll
    for (int c = 0; c < CH; ++c)
#pragma unroll
        for (int mi = 0; mi < 4; ++mi)
#pragma unroll
            for (int ni = 0; ni < 4; ++ni) acc[mi][ni] = __builtin_amdgcn_mfma_f32_16x16x32_bf16(b[c][ni], a[c][mi], acc[mi][ni], 0, 0, 0);
}
template <int MODE>
DEV void cgemm_tile(const Fr& F, const bf16_t* A, const bf16_t* Bt, int K, int rb, int cb, bf16_t* O, int ldc) {
    LAS float* part = (LAS float*)F.lds;
    const int w = F.wave, fr = F.lane & 15, fq = F.lane >> 4;
    const int arow0 = (rb >> 2) * RPB + (rb & 3) * 64;
    int brow[4];
#pragma unroll
    for (int ni = 0; ni < 4; ++ni) {
        if (MODE == 0) brow[ni] = cb * 64 + ni * 16;
        else { const int j = cb * 32 + (ni & 1) * 16; brow[ni] = (j >> 7) * 256 + (ni >> 1) * 128 + (j & 127); }
    }
    const int kslice = K >> 3, steps = kslice >> 5;
    const bf16_t* ap = A + (size_t)(arow0 + fr) * K + w * kslice + 8 * fq;
    const bf16_t* bp = Bt + (size_t)fr * K + w * kslice + 8 * fq;
    f32x4 acc[4][4];
#pragma unroll
    for (int mi = 0; mi < 4; ++mi)
#pragma unroll
        for (int ni = 0; ni < 4; ++ni) acc[mi][ni] = (f32x4){0.f, 0.f, 0.f, 0.f};
    int s = 0;
    for (; s + 4 <= steps; s += 4) cg_chunk<4>(acc, ap + s * 32, bp + s * 32, brow, K);
    if (steps - s == 3) cg_chunk<3>(acc, ap + s * 32, bp + s * 32, brow, K);
    else if (steps - s == 2) cg_chunk<2>(acc, ap + s * 32, bp + s * 32, brow, K);
    else if (steps - s == 1) cg_chunk<1>(acc, ap + s * 32, bp + s * 32, brow, K);
#pragma unroll
    for (int mi = 0; mi < 4; ++mi)
#pragma unroll
        for (int ni = 0; ni < 4; ++ni) *(LAS f32x4*)(part + (w * 64 + 16 * mi + fr) * 64 + ((16 * ni + 4 * fq) ^ (fr << 2))) = acc[mi][ni];
    __syncthreads();
    { const int row = F.tid >> 3, c8 = (F.tid & 7) * 8, sw = (row & 15) << 2;
      if (MODE == 0) {
          f32x4 s0 = (f32x4){0.f, 0.f, 0.f, 0.f}, s1 = s0;
#pragma unroll
          for (int ww = 0; ww < 8; ++ww) { s0 += *(const LAS f32x4*)(part + (ww * 64 + row) * 64 + (c8 ^ sw)); s1 += *(const LAS f32x4*)(part + (ww * 64 + row) * 64 + ((c8 + 4) ^ sw)); }
          u32x4 o; o.x = pk2(s0[0], s0[1]); o.y = pk2(s0[2], s0[3]); o.z = pk2(s1[0], s1[1]); o.w = pk2(s1[2], s1[3]);
          *(u32x4*)(O + (size_t)(arow0 + row) * ldc + cb * 64 + c8) = o;
      } else if (c8 < 32) {
          f32x4 g0 = (f32x4){0.f, 0.f, 0.f, 0.f}, g1 = g0, u0 = g0, u1 = g0;
#pragma unroll
          for (int ww = 0; ww < 8; ++ww) { const LAS float* pr = part + (ww * 64 + row) * 64;
              g0 += *(const LAS f32x4*)(pr + (c8 ^ sw)); g1 += *(const LAS f32x4*)(pr + ((c8 + 4) ^ sw)); u0 += *(const LAS f32x4*)(pr + ((c8 + 32) ^ sw)); u1 += *(const LAS f32x4*)(pr + ((c8 + 36) ^ sw)); }
          float o[8];
#pragma unroll
          for (int j = 0; j < 4; ++j) { o[j] = fsilu(g0[j]) * u0[j]; o[4 + j] = fsilu(g1[j]) * u1[j]; }
          u32x4 ov; ov.x = pk2(o[0], o[1]); ov.y = pk2(o[2], o[3]); ov.z = pk2(o[4], o[5]); ov.w = pk2(o[6], o[7]);
          *(u32x4*)(O + (size_t)(arow0 + row) * ldc + cb * 32 + c8) = ov;
      } }
    __syncthreads();
}

DEV void wt_tile(const Fr& F, const float* src, int src_ld, int ncols_valid, int srccol0, int kt, bf16_t* dst, int K, int p0) {
    LAS float* tile = (LAS float*)F.lds;
    const int t = F.tid;
#pragma unroll
    for (int ps = 0; ps < 2; ++ps) {
        const int kk = (t >> 4) + 32 * ps, c4 = (t & 15) * 4;
        f32x4 v = (f32x4){0.f, 0.f, 0.f, 0.f};
        if (srccol0 + c4 < ncols_valid) v = *(const f32x4*)(src + (size_t)(kt * 64 + kk) * src_ld + srccol0 + c4);
#pragma unroll
        for (int i = 0; i < 4; ++i) tile[kk * 65 + c4 + i] = v[i];
    }
    __syncthreads();
    { const int p = t >> 3, ks = (t & 7) * 8; float o[8];
#pragma unroll
      for (int i = 0; i < 8; ++i) o[i] = tile[(ks + i) * 65 + p];
      u32x4 w; w.x = pk2(o[0], o[1]); w.y = pk2(o[2], o[3]); w.z = pk2(o[4], o[5]); w.w = pk2(o[6], o[7]);
      *(u32x4*)(dst + (size_t)(p0 + p) * K + kt * 64 + ks) = w; }
    __syncthreads();
}

DEV void prologue_a(const Fr& F) {
    constexpr int T_IN = 40 * 16, T_OUT = 16 * 16, T_FI = 88 * 16, T_FO = 16 * 44, T_L = T_IN + T_OUT + T_FI + T_FO;
    for (int idx = F.bid; idx < DEPTH * T_L; idx += F.G) {
        const int l = idx / T_L; int rem = idx % T_L;
        if (rem < T_IN) { const int pt = rem / 16, kt = rem % 16; wt_tile(F, F.in[I_WIN] + (size_t)l * D * INC, INC, INC, pt * 64, kt, wt_ptr(F, l, 0), D, pt * 64); continue; }
        rem -= T_IN;
        if (rem < T_OUT) { const int pt = rem / 16, kt = rem % 16; wt_tile(F, F.in[I_WOUT] + (size_t)l * D * D, D, D, pt * 64, kt, wt_ptr(F, l, 1), D, pt * 64); continue; }
        rem -= T_OUT;
        if (rem < T_FI) { const int pt = rem / 16, kt = rem % 16; const int p0 = pt * 64, unit = p0 >> 8, within = p0 & 255;
            const int sc0 = within < 128 ? unit * 128 + within : FH + unit * 128 + within - 128;
            wt_tile(F, F.in[I_WFI] + (size_t)l * D * 2 * FH, 2 * FH, 2 * FH, sc0, kt, wt_ptr(F, l, 2), D, p0); continue; }
        rem -= T_FI;
        { const int pt = rem / 44, kt = rem % 44; wt_tile(F, F.in[I_WFO] + (size_t)l * FH * D, D, D, pt * 64, kt, wt_ptr(F, l, 3), FH, pt * 64); }
    }
    {
        LAS float* sv = (LAS float*)F.lds;
        LAS float* red = sv + 3 * 1024;
        for (int i = F.tid; i < 3 * 1024; i += NTHR) { const int v = i >> 10, k = i & 1023; const float c = v < 2 ? F.in[I_C][v * 1024 + k] : F.in[I_CCTX][k]; sv[i] = fsilu(c); }
        __syncthreads();
        for (int idx = F.bid; idx < DEPTH * 96; idx += F.G) {
            const int l = idx / 96, cg_ = idx % 96; const int col = cg_ * 64 + F.lane, ks = F.wave;
            const float* wp = F.in[I_WMOD] + (size_t)l * D * 6144 + (size_t)(ks * 128) * 6144 + col;
            float a0 = 0.f, a1 = 0.f, a2 = 0.f;
#pragma unroll 8
            for (int k = 0; k < 128; ++k) { const float w = wp[(size_t)k * 6144]; const int kk = ks * 128 + k; a0 += sv[kk] * w; a1 += sv[1024 + kk] * w; a2 += sv[2048 + kk] * w; }
            red[(ks * 3 + 0) * 64 + F.lane] = a0; red[(ks * 3 + 1) * 64 + F.lane] = a1; red[(ks * 3 + 2) * 64 + F.lane] = a2;
            __syncthreads();
            if (F.tid < 192) { const int v = F.tid >> 6, cc = F.tid & 63; float s = 0.f;
#pragma unroll
                for (int w = 0; w < 8; ++w) s += red[(w * 3 + v) * 64 + cc];
                const int c2 = cg_ * 64 + cc; F.MOD[((size_t)l * 3 + v) * 6144 + c2] = s + F.in[I_BMOD][l * 6144 + c2]; }
            __syncthreads();
        }
    }
    for (int i = F.bid * NTHR + F.tid; i < 256 * 16; i += F.G * NTHR) {
        const int pos = i >> 4, fi = i & 15; const float inv = powf(10000.f, -(float)fi * 2.0f / 32.0f); const float ang = (float)pos * inv;
        float s, c; sincosf(ang, &s, &c); F.ROPE[2 * i] = c; F.ROPE[2 * i + 1] = s;
    }
}

struct RowPass { const bf16_t* Y; const float* xs_lat; const float* xs_ctx; bool out_f32; const float* gate; const float* gy; const float* gn; const float* sh; const float* sc; bool writeA; bool skip_ctx; };
template <bool SRCF32>
DEV void rowpass(const Fr& F, const RowPass& P) {
    const int gw = F.bid * 8 + F.wave, nw = F.G * 8;
    const int rb = (int)(((long)gw * MROWS) / nw), re = (int)(((long)(gw + 1) * MROWS) / nw);
    const int c0 = F.lane * 4;
    int curv = -1;
    f32x4 gg[4], gs[4], shv[4];
#pragma unroll
    for (int q = 0; q < 4; ++q) { gg[q] = (f32x4){0.f, 0.f, 0.f, 0.f}; gs[q] = gg[q]; shv[q] = gg[q]; }
    f32x4 xc[4], xn[4], xl[4]; u32x2 yc[4], yn[4], yl[4], bc[4], bn[4], bl[4];
#define RP_LOAD(r_, x_, y_, b_x) do { \
        if (SRCF32) { const int b_ = (r_) / RPB, p_ = (r_) % RPB; const bool ic_ = p_ < CTXL; \
            const float* sp_ = ic_ ? P.xs_ctx + (size_t)(b_ * CTXL + p_) * D : P.xs_lat + (size_t)(b_ * SEQ + p_ - CTXL) * D; \
            _Pragma("unroll") for (int q = 0; q < 4; ++q) x_[q] = *(const f32x4*)(sp_ + q * 256 + c0); } \
        else { _Pragma("unroll") for (int q = 0; q < 4; ++q) b_x[q] = *(const u32x2*)(F.XB + (size_t)(r_) * D + q * 256 + c0); } \
        if (P.Y) { _Pragma("unroll") for (int q = 0; q < 4; ++q) y_[q] = *(const u32x2*)(P.Y + (size_t)(r_) * D + q * 256 + c0); } } while (0)
#pragma unroll
    for (int q = 0; q < 4; ++q) { yc[q] = (u32x2){0u, 0u}; yn[q] = yc[q]; yl[q] = yc[q]; bc[q] = yc[q]; bn[q] = yc[q]; bl[q] = yc[q]; xc[q] = (f32x4){0.f, 0.f, 0.f, 0.f}; xn[q] = xc[q]; xl[q] = xc[q]; }
    if (rb < re) RP_LOAD(rb, xc, yc, bc);
    if (rb + 1 < re) RP_LOAD(rb + 1, xn, yn, bn);
    for (int r = rb; r < re; ++r) {
        if (r + 2 < re) RP_LOAD(r + 2, xl, yl, bl);
        const int b = r / RPB, p = r % RPB; const bool isctx = p < CTXL; const int v = isctx ? 2 : b;
        if (!(isctx && P.skip_ctx)) {
            if (v != curv) { curv = v;
#pragma unroll
                for (int q = 0; q < 4; ++q) { const int col = q * 256 + c0;
                    if (P.Y) { const f32x4 g = *(const f32x4*)(P.gate + v * 6144 + col), gy = *(const f32x4*)(P.gy + col); gg[q] = g * gy; }
                    if (P.writeA) { const f32x4 gn = *(const f32x4*)(P.gn + col), sc = *(const f32x4*)(P.sc + v * 6144 + col); gs[q] = gn * (sc + 1.f); shv[q] = *(const f32x4*)(P.sh + v * 6144 + col); } } }
            f32x4 x[4];
#pragma unroll
            for (int q = 0; q < 4; ++q) { if (SRCF32) x[q] = xc[q]; else { float f[4]; unpack4(bc[q], f); x[q] = (f32x4){f[0], f[1], f[2], f[3]}; } }
            if (P.Y) {
                float y[16]; float ss = 0.f;
#pragma unroll
                for (int q = 0; q < 4; ++q) unpack4(yc[q], y + 4 * q);
#pragma unroll
                for (int i = 0; i < 16; ++i) ss += y[i] * y[i];
                ss = wave_sum(ss); const float rstd = rsqrtf(ss * (1.f / D) + EPS);
#pragma unroll
                for (int q = 0; q < 4; ++q) {
#pragma unroll
                    for (int jj = 0; jj < 4; ++jj) x[q][jj] += gg[q][jj] * (y[4 * q + jj] * rstd); }
                if (P.out_f32) { float* dst = F.out + (size_t)(b * SEQ + p - CTXL) * D;
#pragma unroll
                    for (int q = 0; q < 4; ++q) *(f32x4*)(dst + q * 256 + c0) = x[q]; }
                else {
#pragma unroll
                    for (int q = 0; q < 4; ++q) { u32x2 w; w.x = pk2(x[q][0], x[q][1]); w.y = pk2(x[q][2], x[q][3]); *(u32x2*)(F.XB + (size_t)r * D + q * 256 + c0) = w;
                        float f[4]; unpack4(w, f); x[q] = (f32x4){f[0], f[1], f[2], f[3]}; } }
            }
            if (P.writeA) {
                float ss = 0.f;
#pragma unroll
                for (int q = 0; q < 4; ++q)
#pragma unroll
                    for (int jj = 0; jj < 4; ++jj) ss += x[q][jj] * x[q][jj];
                ss = wave_sum(ss); const float rstd = rsqrtf(ss * (1.f / D) + EPS);
#pragma unroll
                for (int q = 0; q < 4; ++q) { float o[4];
#pragma unroll
                    for (int jj = 0; jj < 4; ++jj) o[jj] = x[q][jj] * rstd * gs[q][jj] + shv[q][jj];
                    u32x2 w; w.x = pk2(o[0], o[1]); w.y = pk2(o[2], o[3]); *(u32x2*)(F.A + (size_t)r * D + q * 256 + c0) = w; }
            }
        }
#pragma unroll
        for (int q = 0; q < 4; ++q) { xc[q] = xn[q]; yc[q] = yn[q]; xn[q] = xl[q]; yn[q] = yl[q]; bc[q] = bn[q]; bn[q] = bl[q]; }
    }
#undef RP_LOAD
}

struct SguPre { u32x4 v0, v1; u32x2 up[4]; float bias; };
DEV void sgu_prefetch(const Fr& F, int l, int it, SguPre& P) {
    const int b = it / 520, ch = (it >> 2) % NCH, h = it & 3; const int row0 = b * RPB + ch * 128;
    const int tid = F.tid, w = F.wave, fr = F.lane & 15, fq = F.lane >> 4;
    const int t = tid >> 2, part = tid & 3; const bf16_t* zp = F.Z + (size_t)(row0 + t) * ZS + ZC_SGU + 256 + h * 64 + part * 16;
    P.v0 = *(const u32x4*)zp; P.v1 = *(const u32x4*)(zp + 8);
#pragma unroll
    for (int nt = 0; nt < 4; ++nt) P.up[nt] = *(const u32x2*)(F.Z + (size_t)(row0 + 16 * w + fr) * ZS + ZC_SGU + h * 64 + 16 * nt + 4 * fq);
    P.bias = F.in[I_SGUB][(l * 4 + h) * 128 + 16 * w + fr];
}
DEV void sgu_phase(const Fr& F, int l, int it0) {
    LAS bf16_t* Ws = (LAS bf16_t*)F.lds;
    LAS bf16_t* Vh = Ws + 128 * 136;
    const int tid = F.tid, w = F.wave, fr = F.lane & 15, fq = F.lane >> 4;
    int it = it0; while (it < 1040 && (l + 1 == DEPTH && (it >> 2) % NCH < 2)) it += F.G;
    if (it >= 1040) return;
    int h = -1;
    SguPre P; sgu_prefetch(F, l, it, P);
    while (it < 1040) {
        if ((it & 3) != h) { h = it & 3; const float* W = F.in[I_SGUW] + (size_t)(l * 4 + h) * 128 * 128;
#pragma unroll
          for (int i = 0; i < 8; ++i) { const int idx = tid + NTHR * i; const int t = idx >> 5, s4 = (idx & 31) * 4; const f32x4 v = *(const f32x4*)(W + idx * 4);
              u32x2 o; o.x = pk2(v[0], v[1]); o.y = pk2(v[2], v[3]); *(LAS u32x2*)(Ws + t * 136 + s4) = o; } }
        int nx = it + F.G; while (nx < 1040 && (l + 1 == DEPTH && (nx >> 2) % NCH < 2)) nx += F.G;
        const int b = it / 520, ch = (it >> 2) % NCH; const int row0 = b * RPB + ch * 128;
        { const int t = tid >> 2, part = tid & 3;
          float x[16]; unpack8(P.v0, x); unpack8(P.v1, x + 8);
          float s = 0.f;
#pragma unroll
          for (int i = 0; i < 16; ++i) { x[i] = fgelu(x[i]); s += x[i]; }
          s += __shfl_xor(s, 1); s += __shfl_xor(s, 2); const float mu = s * (1.f / 64.f);
          float q = 0.f;
#pragma unroll
          for (int i = 0; i < 16; ++i) { x[i] -= mu; q += x[i] * x[i]; }
          q += __shfl_xor(q, 1); q += __shfl_xor(q, 2); const float rstd = rsqrtf(q * (1.f / 64.f) + EPS);
#pragma unroll
          for (int i = 0; i < 16; i += 2) *(LAS unsigned*)(Vh + t * 72 + part * 16 + i) = pk2(x[i] * rstd, x[i + 1] * rstd); }
        u32x2 up[4];
#pragma unroll
        for (int nt = 0; nt < 4; ++nt) up[nt] = P.up[nt];
        const float bias = P.bias;
        __syncthreads();
        if (nx < 1040) sgu_prefetch(F, l, nx, P);
        f32x4 acc[4];
#pragma unroll
        for (int nt = 0; nt < 4; ++nt) { acc[nt] = (f32x4){0.f, 0.f, 0.f, 0.f};
#pragma unroll
            for (int k0 = 0; k0 < 128; k0 += 32) { const bf16x8 xf = *(const LAS bf16x8*)(Ws + (16 * w + fr) * 136 + k0 + fq * 8); const bf16x8 yf = tr_frag(Vh, 72, k0, 16 * nt, F.lane);
                acc[nt] = __builtin_amdgcn_mfma_f32_16x16x32_bf16(yf, xf, acc[nt], 0, 0, 0); } }
        { const int t = 16 * w + fr;
#pragma unroll
          for (int nt = 0; nt < 4; ++nt) { const int d0 = 16 * nt + 4 * fq; float u[4]; unpack4(up[nt], u);
              float o[4];
#pragma unroll
              for (int j = 0; j < 4; ++j) o[j] = fgelu(u[j]) * (acc[nt][j] + bias);
              u32x2 wv; wv.x = pk2(o[0], o[1]); wv.y = pk2(o[2], o[3]); *(u32x2*)(F.MIX + (size_t)(row0 + t) * D + h * 64 + d0) = wv; } }
        __syncthreads();
        it = nx;
    }
}

struct PoolPre { u32x4 r[3]; };
DEV void pool_prefetch(const Fr& F, int it, PoolPre& P) {
    const int b = it / 520, ch = (it >> 2) % NCH, g = it & 3; const int tid = F.tid;
    const bool isctx = ch < 2; const int seqlen = isctx ? CTXL : SEQ; const int p0 = isctx ? ch * 128 : (ch - 2) * 128; const int seqrow0 = b * RPB + (isctx ? 0 : CTXL);
#pragma unroll
    for (int i = 0; i < 3; ++i) { const int idx = tid + NTHR * i; const int rr = idx >> 3, c8 = (idx & 7) * 8; const int p = p0 - 8 + rr; P.r[i] = (u32x4){0u, 0u, 0u, 0u};
        if (idx < 144 * 8 && p >= 0 && p < seqlen) P.r[i] = *(const u32x4*)(F.Z + (size_t)(seqrow0 + p) * ZS + ZC_POOL + g * 64 + c8); }
}
DEV void pool_phase(const Fr& F, int l, int it0, int stride) {
    LAS float* Zt = (LAS float*)F.lds;
    LAS bf16_t* Dm = (LAS bf16_t*)(F.lds + 144 * 64 * 4);
    LAS bf16_t* Wp = Dm + 128 * 72;
    const int tid = F.tid, w = F.wave, fr = F.lane & 15, fq = F.lane >> 4;
    int it = it0; while (it < 1040 && (l + 1 == DEPTH && (it >> 2) % NCH < 2)) it += stride;
    if (it >= 1040) return;
    int g = -1;
    PoolPre P; pool_prefetch(F, it, P);
    while (it < 1040) {
        int nx = it + stride; while (nx < 1040 && (l + 1 == DEPTH && (nx >> 2) % NCH < 2)) nx += stride;
        const int b = it / 520, ch = (it >> 2) % NCH;
        if ((it & 3) != g) { g = it & 3;
#pragma unroll
            for (int i = 0; i < 2; ++i) { const int idx = tid + NTHR * i; const int c = idx >> 4, d4 = (idx & 15) * 4; const f32x4 v = *(const f32x4*)(F.in[I_POOLW] + (size_t)(l * 4 + g) * 4096 + idx * 4);
                u32x2 o; o.x = pk2(v[0], v[1]); o.y = pk2(v[2], v[3]); *(LAS u32x2*)(Wp + c * 72 + d4) = o; } }
        const bool isctx = ch < 2; const int seqlen = isctx ? CTXL : SEQ; const int p0 = isctx ? ch * 128 : (ch - 2) * 128; const int row0 = b * RPB + ch * 128;
        const int win = 2 << g, half = win >> 1;
#pragma unroll
        for (int i = 0; i < 3; ++i) { const int idx = tid + NTHR * i; if (idx < 144 * 8) { const int rr = idx >> 3, c8 = (idx & 7) * 8; float x[8]; unpack8(P.r[i], x);
#pragma unroll
            for (int j = 0; j < 8; ++j) Zt[rr * 64 + c8 + j] = x[j]; } }
        __syncthreads();
        if (nx < 1040) pool_prefetch(F, nx, P);
        { const int t = tid >> 2, part = tid & 3; const int p = p0 + t; const int lo = max(p - half, 0), hi = min(p + win - half, seqlen); const float rc = 1.f / (float)(hi - lo);
          float s[16];
#pragma unroll
          for (int j = 0; j < 16; ++j) s[j] = 0.f;
          for (int o = -half; o < half; ++o) {
#pragma unroll
              for (int j = 0; j < 16; ++j) s[j] += Zt[(t + 8 + o) * 64 + part * 16 + j]; }
#pragma unroll
          for (int j = 0; j < 16; j += 2) { const float a0 = s[j] * rc - Zt[(t + 8) * 64 + part * 16 + j], a1 = s[j + 1] * rc - Zt[(t + 8) * 64 + part * 16 + j + 1];
              *(LAS unsigned*)(Dm + t * 72 + part * 16 + j) = pk2(a0, a1); } }
        __syncthreads();
        f32x4 acc[4];
#pragma unroll
        for (int nt = 0; nt < 4; ++nt) { acc[nt] = (f32x4){0.f, 0.f, 0.f, 0.f};
#pragma unroll
            for (int k0 = 0; k0 < 64; k0 += 32) { const bf16x8 xf = *(const LAS bf16x8*)(Dm + (16 * w + fr) * 72 + k0 + fq * 8); const bf16x8 yf = tr_frag(Wp, 72, k0, 16 * nt, F.lane);
                acc[nt] = __builtin_amdgcn_mfma_f32_16x16x32_bf16(yf, xf, acc[nt], 0, 0, 0); } }
        { const int t = 16 * w + fr;
#pragma unroll
          for (int nt = 0; nt < 4; ++nt) { const int d0 = 16 * nt + 4 * fq; const f32x4 ps = *(const f32x4*)(F.in[I_POOLS] + l * 256 + g * 64 + d0);
              u32x2 wv; wv.x = pk2(acc[nt][0] * ps[0], acc[nt][1] * ps[1]); wv.y = pk2(acc[nt][2] * ps[2], acc[nt][3] * ps[3]);
              *(u32x2*)(F.MIX + (size_t)(row0 + t) * D + 768 + g * 64 + d0) = wv; } }
        __syncthreads();
        it = nx;
    }
}

DEV void load_rope8(const Fr& F, const bf16_t* zp, int c8, int n, bool rope, float* o) {
    unpack8(*(const u32x4*)(zp + c8), o);
    if (rope) {
        const bool second = (c8 & 16) != 0; float pr[8]; unpack8(*(const u32x4*)(zp + (second ? c8 - 16 : c8 + 16)), pr);
        const int pos = (c8 >= 32) ? (n & 63) : (n >> 6); const float* tb = F.ROPE + (size_t)(pos * 16 + (c8 & 8)) * 2;
#pragma unroll
        for (int e = 0; e < 8; ++e) { const float c = tb[2 * e], s = tb[2 * e + 1]; o[e] = second ? (o[e] * c + pr[e] * s) : (o[e] * c - pr[e] * s); }
    }
}
DEV bf16x8 pack8(const float* x) { u32x4 o; o.x = pk2(x[0], x[1]); o.y = pk2(x[2], x[3]); o.z = pk2(x[4], x[5]); o.w = pk2(x[6], x[7]); return __builtin_bit_cast(bf16x8, o); }
DEV void attn_item(const Fr& F, int l, int b, int qb, int kvh, bool ctxq) {
    LAS bf16_t* Ks = (LAS bf16_t*)F.lds;
    LAS bf16_t* Vs = Ks + 128 * 72;
    LAS bf16_t* Ps = Vs + 128 * 72;
    const int tid = F.tid, w = F.wave, fr = F.lane & 15, fq = F.lane >> 4;
    const int qrow0 = b * RPB + (ctxq ? qb * 128 : CTXL + qb * 128);
    const int g = w >> 2, rq = w & 3, r0 = rq * 32;
    bf16x8 xq[2][2];
#pragma unroll
    for (int mt = 0; mt < 2; ++mt)
#pragma unroll
        for (int ks = 0; ks < 2; ++ks) { const int t = r0 + 16 * mt + fr; float x[8];
            load_rope8(F, F.Z + (size_t)(qrow0 + t) * ZS + ZC_AQ + (kvh * 2 + g) * 64, 32 * ks + 8 * fq, qb * 128 + t, !ctxq, x);
#pragma unroll
            for (int e = 0; e < 8; ++e) x[e] *= 0.18033688011f;
            xq[mt][ks] = pack8(x); }
    const float sink = F.in[I_SINK][l * 4 + kvh * 2 + g] * 1.44269504089f;
    float mrow[2], lrow[2]; f32x4 O[2][4];
#pragma unroll
    for (int mt = 0; mt < 2; ++mt) { mrow[mt] = sink; lrow[mt] = 1.f;
#pragma unroll
        for (int n = 0; n < 4; ++n) O[mt][n] = (f32x4){0.f, 0.f, 0.f, 0.f}; }
    LAS bf16_t* Pw = Ps + w * 32 * 136;
    const int ktl[5] = {0, 1, 2, 3, 4};
    int kt = 0; const int nkt = ctxq ? 2 : 5;
    u32x4 rk[2], rp[2], rv[2];
    auto tile_ok = [&](int k) { const int kb = qb + k - 3; return k < 2 || (kb >= 0 && kb < SEQ / 128); };
#define ATT_PREFETCH(k) do { const int kb_ = qb + (k) - 3; const int krow0_ = b * RPB + ((k) < 2 ? (k) * 128 : CTXL + kb_ * 128); \
        _Pragma("unroll") for (int i = 0; i < 2; ++i) { const int idx = tid + NTHR * i; const int s_ = idx >> 3, c8 = (idx & 7) * 8; \
            const bf16_t* zp = F.Z + (size_t)(krow0_ + s_) * ZS + ZC_AK + kvh * 64; \
            rk[i] = *(const u32x4*)(zp + c8); rp[i] = *(const u32x4*)(zp + ((c8 & 16) ? c8 - 16 : c8 + 16)); \
            rv[i] = *(const u32x4*)(F.Z + (size_t)(krow0_ + s_) * ZS + ZC_AV + kvh * 64 + c8); } } while (0)
    (void)ktl;
    while (kt < nkt && !tile_ok(kt)) ++kt;
    if (kt < nkt) ATT_PREFETCH(kt);
    while (kt < nkt) {
        const int kb = qb + kt - 3; const bool rope = kt >= 2;
        __syncthreads();
#pragma unroll
        for (int i = 0; i < 2; ++i) { const int idx = tid + NTHR * i; const int s_ = idx >> 3, c8 = (idx & 7) * 8;
            float x[8]; unpack8(rk[i], x);
            if (rope) { float pr[8]; unpack8(rp[i], pr); const bool second = (c8 & 16) != 0; const int n = kb * 128 + s_;
                const int pos = (c8 >= 32) ? (n & 63) : (n >> 6); const float* tb = F.ROPE + (size_t)(pos * 16 + (c8 & 8)) * 2;
#pragma unroll
                for (int e = 0; e < 8; ++e) { const float c = tb[2 * e], sn = tb[2 * e + 1]; x[e] = second ? (x[e] * c + pr[e] * sn) : (x[e] * c - pr[e] * sn); } }
            *(LAS bf16x8*)(Ks + s_ * 72 + c8) = pack8(x);
            *(LAS u32x4*)(Vs + s_ * 72 + c8) = rv[i]; }
        __syncthreads();
        int kn = kt + 1; while (kn < nkt && !tile_ok(kn)) ++kn;
        if (kn < nkt) ATT_PREFETCH(kn);
        const int nlo = (kt == 2) ? 2 * rq : 0, nhi = (kt == 4) ? 2 * rq + 2 : 8;
        f32x4 sc[2][8];
#pragma unroll
        for (int nt = 0; nt < 8; ++nt) { if (nt >= nlo && nt < nhi) {
            const bf16x8 y0 = *(const LAS bf16x8*)(Ks + (nt * 16 + fr) * 72 + 8 * fq), y1 = *(const LAS bf16x8*)(Ks + (nt * 16 + fr) * 72 + 32 + 8 * fq);
#pragma unroll
            for (int mt = 0; mt < 2; ++mt) { f32x4 a = __builtin_amdgcn_mfma_f32_16x16x32_bf16(y0, xq[mt][0], (f32x4){0.f, 0.f, 0.f, 0.f}, 0, 0, 0);
                sc[mt][nt] = __builtin_amdgcn_mfma_f32_16x16x32_bf16(y1, xq[mt][1], a, 0, 0, 0); } }
            else { sc[0][nt] = (f32x4){0.f, 0.f, 0.f, 0.f}; sc[1][nt] = sc[0][nt]; } }
        float scl[2];
#pragma unroll
        for (int mt = 0; mt < 2; ++mt) {
            const int tl = r0 + mt * 16 + fr;
            float mx = -INFINITY;
#pragma unroll
            for (int nt = 0; nt < 8; ++nt) { if (nt >= nlo && nt < nhi) {
                const bool dg = (kt == 2 || kt == 4) && (nt == 2 * rq + mt);
                if (dg) {
#pragma unroll
                    for (int j = 0; j < 4; ++j) { const int si = nt * 16 + 4 * fq + j; const bool ok = (kt == 2) ? (si >= tl) : (si <= tl); sc[mt][nt][j] = ok ? sc[mt][nt][j] : -INFINITY; } }
                else if ((kt == 2 && nt < 2 * rq + mt) || (kt == 4 && nt > 2 * rq + mt)) sc[mt][nt] = (f32x4){-INFINITY, -INFINITY, -INFINITY, -INFINITY};
                mx = fmaxf(fmaxf(mx, fmaxf(sc[mt][nt][0], sc[mt][nt][1])), fmaxf(sc[mt][nt][2], sc[mt][nt][3])); } }
            mx = fmaxf(mx, __shfl_xor(mx, 16)); mx = fmaxf(mx, __shfl_xor(mx, 32));
            const float mn = fmaxf(mrow[mt], mx); scl[mt] = __builtin_amdgcn_exp2f(mrow[mt] - mn);
            float sum = 0.f;
#pragma unroll
            for (int nt = 0; nt < 8; ++nt) { if (nt >= nlo && nt < nhi) { float p[4];
#pragma unroll
                for (int j = 0; j < 4; ++j) { p[j] = __builtin_amdgcn_exp2f(sc[mt][nt][j] - mn); sum += p[j]; }
                u32x2 pw; pw.x = pk2(p[0], p[1]); pw.y = pk2(p[2], p[3]); *(LAS u32x2*)(Pw + (mt * 16 + fr) * 136 + nt * 16 + 4 * fq) = pw; } }
            sum += __shfl_xor(sum, 16); sum += __shfl_xor(sum, 32);
            lrow[mt] = lrow[mt] * scl[mt] + sum; mrow[mt] = mn;
#pragma unroll
            for (int n2 = 0; n2 < 4; ++n2) O[mt][n2] *= scl[mt];
        }
        __builtin_amdgcn_wave_barrier();
        const int clo = nlo >> 1, chi = nhi >> 1;
#pragma unroll
        for (int c = 0; c < 4; ++c) { if (c >= clo && c < chi) {
            const bf16x8 p0 = *(const LAS bf16x8*)(Pw + fr * 136 + 32 * c + 8 * fq), p1 = *(const LAS bf16x8*)(Pw + (16 + fr) * 136 + 32 * c + 8 * fq);
#pragma unroll
            for (int n2 = 0; n2 < 4; ++n2) { const bf16x8 vf = tr_frag(Vs, 72, 32 * c, 16 * n2, F.lane);
                O[0][n2] = __builtin_amdgcn_mfma_f32_16x16x32_bf16(vf, p0, O[0][n2], 0, 0, 0); O[1][n2] = __builtin_amdgcn_mfma_f32_16x16x32_bf16(vf, p1, O[1][n2], 0, 0, 0); } } }
        __builtin_amdgcn_wave_barrier();
        kt = kn;
    }
#undef ATT_PREFETCH
#pragma unroll
    for (int mt = 0; mt < 2; ++mt) { const int t = r0 + mt * 16 + fr; const float rl = 1.f / lrow[mt];
#pragma unroll
        for (int n2 = 0; n2 < 4; ++n2) { u32x2 wv; wv.x = pk2(O[mt][n2][0] * rl, O[mt][n2][1] * rl); wv.y = pk2(O[mt][n2][2] * rl, O[mt][n2][3] * rl);
            *(u32x2*)(F.MIX + (size_t)(qrow0 + t) * D + 512 + (kvh * 2 + g) * 64 + n2 * 16 + 4 * fq) = wv; } }
    __syncthreads();
}

struct GateV { float li0, li1, bc0, bc1; };
struct GateRaw { float li0, li1, lp0, lp1; };
DEV GateRaw ml_gates_load(const Fr& F, int l, int row0, int h, int dir, int lane) {
    const int u0 = 2 * lane, u1 = u0 + 1; const int s0 = dir ? 127 - u0 : u0, s1 = dir ? 127 - u1 : u1;
    const float bi = F.in[I_GATEB][l * 16 + (dir * 2) * 4 + h], bf = F.in[I_GATEB][l * 16 + (dir * 2 + 1) * 4 + h];
    const bf16_t* z0 = F.Z + (size_t)(row0 + s0) * ZS + ZC_MG, * z1 = F.Z + (size_t)(row0 + s1) * ZS + ZC_MG;
    GateRaw r; r.li0 = bf2f(z0[(dir * 2) * 4 + h]) + bi; r.li1 = bf2f(z1[(dir * 2) * 4 + h]) + bi;
    r.lp0 = bf2f(z0[(dir * 2 + 1) * 4 + h]) + bf; r.lp1 = bf2f(z1[(dir * 2 + 1) * 4 + h]) + bf; return r;
}
DEV GateV ml_gates_fin(const GateRaw& g, int lane) {
    GateV r; r.li0 = g.li0; r.li1 = g.li1;
    const float lf0 = logsigmoid(g.lp0), lf1 = logsigmoid(g.lp1);
    const float incl = wave_scan_add(lf0 + lf1, lane);
    r.bc1 = incl; r.bc0 = incl - lf1; return r;
}
DEV void conv_silu8(const Fr& F, int seqrow0, int seqlen, int p, int zc, const float* cw, float scale, float* o) {
    float a[8], x[8];
#pragma unroll
    for (int j = 0; j < 8; ++j) a[j] = 0.f;
#pragma unroll
    for (int tap = 0; tap < 3; ++tap) { const int pp = p + tap - 1; if (pp >= 0 && pp < seqlen) { unpack8(*(const u32x4*)(F.Z + (size_t)(seqrow0 + pp) * ZS + zc), x);
        const f32x4 w0 = *(const f32x4*)(cw + tap * 512), w1 = *(const f32x4*)(cw + tap * 512 + 4);
#pragma unroll
        for (int j = 0; j < 4; ++j) { a[j] += x[j] * w0[j]; a[4 + j] += x[4 + j] * w1[j]; } } }
#pragma unroll
    for (int j = 0; j < 8; ++j) o[j] = fsilu(a[j]) * scale;
}

DEV void ml_local_item(const Fr& F, int l, int b, int ch, int h) {
    LAS bf16_t* Vs = (LAS bf16_t*)F.lds;
    LAS bf16_t* KTf = Vs + 128 * 72;
    LAS bf16_t* KTb = KTf + 128 * 72;
    LAS float* wv = (LAS float*)(KTb + 128 * 72);
    const int tid = F.tid, w = F.wave, lane = F.lane, fr = lane & 15, fq = lane >> 4;
    const bool isctx = ch < 2; const int seqlen = isctx ? CTXL : SEQ; const int p0 = isctx ? ch * 128 : (ch - 2) * 128;
    const int seqrow0 = b * RPB + (isctx ? 0 : CTXL); const int row0 = b * RPB + ch * 128;
    GateRaw graw; graw.li0 = graw.li1 = graw.lp0 = graw.lp1 = 0.f;
    if (w < 2) graw = ml_gates_load(F, l, row0, h, w, lane);
    u32x4 vv[2]; float kk[2][8];
#pragma unroll
    for (int i = 0; i < 2; ++i) { const int idx = tid + NTHR * i; const int s = idx >> 3, c8 = (idx & 7) * 8;
        vv[i] = *(const u32x4*)(F.Z + (size_t)(row0 + s) * ZS + ZC_MV + h * 64 + c8);
        conv_silu8(F, seqrow0, seqlen, p0 + s, ZC_MK + h * 64 + c8, F.in[I_CONVW] + l * 1536 + 256 + h * 64 + c8, 0.125f, kk[i]);
        *(bf16x8*)(F.A + (size_t)(row0 + s) * 256 + h * 64 + c8) = pack8(kk[i]); }
    if (w < 2) { const int dir = w; const GateV gv = ml_gates_fin(graw, lane);
        const float a0 = gv.li0 - gv.bc0, a1 = gv.li1 - gv.bc1; const float A = wave_max(fmaxf(a0, a1));
        const int u0 = 2 * lane; const int s0 = dir ? 127 - u0 : u0, s1 = dir ? 126 - u0 : u0 + 1;
        wv[dir * 128 + s0] = __expf(a0 - A); wv[dir * 128 + s1] = __expf(a1 - A);
        const int chain = dir * 8 + b * 4 + h;
        if (lane == 63) { F.AL[chain * NCH + ch] = A; F.BE[chain * NCH + ch] = gv.bc1; } }
    __syncthreads();
#pragma unroll
    for (int i = 0; i < 2; ++i) { const int idx = tid + NTHR * i; const int s = idx >> 3, c8 = (idx & 7) * 8;
        *(LAS u32x4*)(Vs + s * 72 + c8) = vv[i];
        const float wf = wv[s], wb = wv[128 + s];
        float kf[8], kb[8];
#pragma unroll
        for (int j = 0; j < 8; ++j) { kf[j] = kk[i][j] * wf; kb[j] = kk[i][j] * wb; }
        *(LAS bf16x8*)(KTf + s * 72 + c8) = pack8(kf); *(LAS bf16x8*)(KTb + s * 72 + c8) = pack8(kb); }
    __syncthreads();
    { const int dir = w >> 2, mt = w & 3; const int chain = dir * 8 + b * 4 + h; float* cl = F.CL + ((size_t)chain * NCH + ch) * 4096;
      const LAS bf16_t* KT = dir ? KTb : KTf;
      bf16x8 vfr[4];
#pragma unroll
      for (int c = 0; c < 4; ++c) vfr[c] = tr_frag(Vs, 72, 32 * c, 16 * mt, lane);
#pragma unroll
      for (int nt = 0; nt < 4; ++nt) { f32x4 acc = (f32x4){0.f, 0.f, 0.f, 0.f};
#pragma unroll
          for (int c = 0; c < 4; ++c) acc = __builtin_amdgcn_mfma_f32_16x16x32_bf16(tr_frag(KT, 72, 32 * c, 16 * nt, lane), vfr[c], acc, 0, 0, 0);
          *(f32x4*)(cl + (16 * mt + fr) * 64 + 16 * nt + 4 * fq) = acc; } }
    if (tid < 128) { const int dir = tid >> 6, d = tid & 63; const LAS bf16_t* KT = (dir ? KTb : KTf) + d; float s = 0.f;
        for (int i = 0; i < 128; ++i) s += bf2f(KT[i * 72]);
        const int chain = dir * 8 + b * 4 + h; F.NL[((size_t)chain * NCH + ch) * 64 + d] = s; }
    __syncthreads();
}

DEV int scan_order(int dir, int i) { return dir == 0 ? i : (i == 0 ? 1 : (i == 1 ? 0 : 131 - i)); }
DEV void ml_scan(const Fr& F) {
    const int gidx = F.bid * NTHR + F.tid;
    if (gidx >= 16 * 4160) return;
    const int chain = gidx / 4160, e = gidx % 4160, dir = chain >> 3;
    float* base; int stride;
    if (e < 4096) { base = F.CL + (size_t)chain * NCH * 4096 + e; stride = 4096; } else { base = F.NL + (size_t)chain * NCH * 64 + (e - 4096); stride = 64; }
    const float* al = F.AL + chain * NCH; const float* be = F.BE + chain * NCH; float* ms = F.MS + chain * NCH;
    float st = 0.f, m = 0.f;
    for (int i0 = 0; i0 < NCH; i0 += 26) {
        float v[26], A[26], B[26];
#pragma unroll
        for (int u = 0; u < 26; ++u) { const int cc = scan_order(dir, i0 + u); v[u] = base[(size_t)cc * stride]; A[u] = al[cc]; B[u] = be[cc]; }
#pragma unroll
        for (int u = 0; u < 26; ++u) { const int cc = scan_order(dir, i0 + u); const float Ml = fmaxf(m, A[u]); const float dec = __expf(m - Ml), scl = __expf(A[u] - Ml);
            base[(size_t)cc * stride] = st; if (e == 0) ms[cc] = m;
            st = dec * st + scl * v[u]; m = B[u] + Ml; }
    }
}

typedef float f32x2 __attribute__((ext_vector_type(2)));
DEV f32x2 fsilu2(f32x2 a) { const f32x2 t = a * -1.44269504089f; f32x2 e; e.x = __builtin_amdgcn_exp2f(t.x); e.y = __builtin_amdgcn_exp2f(t.y); const f32x2 d = e + 1.0f;
    f32x2 r; r.x = __builtin_amdgcn_rcpf(d.x); r.y = __builtin_amdgcn_rcpf(d.y); return a * r; }
struct MoPre { u32x4 v[2], k[2], q[2][3]; f32x4 ct[4]; GateRaw g; float mp, nvv; };
DEV void ml_out_prefetch(const Fr& F, int l, int it, MoPre& P) {
    const int b = it / 520, ch = (it >> 2) % NCH, h = it & 3;
    const int tid = F.tid, w = F.wave, lane = F.lane;
    const bool isctx = ch < 2; const int seqlen = isctx ? CTXL : SEQ; const int p0 = isctx ? ch * 128 : (ch - 2) * 128;
    const int seqrow0 = b * RPB + (isctx ? 0 : CTXL); const int row0 = b * RPB + ch * 128;
    P.g.li0 = P.g.li1 = P.g.lp0 = P.g.lp1 = 0.f; P.mp = 0.f;
    if (w < 2) { P.g = ml_gates_load(F, l, row0, h, w, lane); P.mp = F.MS[(w * 8 + b * 4 + h) * NCH + ch]; }
#pragma unroll
    for (int i = 0; i < 2; ++i) { const int idx = tid + NTHR * i; const int s = idx >> 3, c8 = (idx & 7) * 8;
        P.v[i] = *(const u32x4*)(F.Z + (size_t)(row0 + s) * ZS + ZC_MV + h * 64 + c8);
        P.k[i] = *(const u32x4*)(F.A + (size_t)(row0 + s) * 256 + h * 64 + c8);
#pragma unroll
        for (int tap = 0; tap < 3; ++tap) { const int pp = p0 + s + tap - 1; P.q[i][tap] = (u32x4){0u, 0u, 0u, 0u};
            if (pp >= 0 && pp < seqlen) P.q[i][tap] = *(const u32x4*)(F.Z + (size_t)(seqrow0 + pp) * ZS + ZC_MQ + h * 64 + c8); } }
#pragma unroll
    for (int i = 0; i < 4; ++i) { const int idx = tid + NTHR * i; const int dir = idx >> 10, e = (idx >> 4) & 63, d4 = (idx & 15) * 4; const int chain = dir * 8 + b * 4 + h;
        P.ct[i] = *(const f32x4*)(F.CL + ((size_t)chain * NCH + ch) * 4096 + e * 64 + d4); }
    P.nvv = 0.f;
    if (tid < 128) { const int dir = tid >> 6, d = tid & 63; const int chain = dir * 8 + b * 4 + h; P.nvv = F.NL[((size_t)chain * NCH + ch) * 64 + d]; }
}
DEV void ml_out_item(const Fr& F, int l, int it, MoPre& P, int nx) {
    const int b = it / 520, ch = (it >> 2) % NCH, h = it & 3;
    LAS bf16_t* Qs = (LAS bf16_t*)F.lds;
    LAS bf16_t* Ks = Qs + 128 * 72;
    LAS bf16_t* Vs = Ks + 128 * 72;
    LAS bf16_t* CT = Vs + 128 * 72;
    LAS bf16_t* Ps = CT + 2 * 64 * 72;
    LAS float* gvv = (LAS float*)(Ps + 8 * 16 * 136);
    LAS float* nv = gvv + 2 * 4 * 128;
    const int tid = F.tid, w = F.wave, lane = F.lane, fr = lane & 15, fq = lane >> 4;
    const int row0 = b * RPB + ch * 128;
    u32x2 ogp[4]; f32x4 ngp[4];
#pragma unroll
    for (int n2 = 0; n2 < 4; ++n2) { const int e0 = 16 * n2 + 4 * fq; ogp[n2] = *(const u32x2*)(F.Z + (size_t)(row0 + 16 * w + fr) * ZS + ZC_MO + h * 64 + e0); ngp[n2] = *(const f32x4*)(F.in[I_MNORMG] + l * 256 + h * 64 + e0); }
    if (w < 2) { const int dir = w; const GateV gv = ml_gates_fin(P.g, lane); const float mp = P.mp;
        const float a0 = gv.li0 - gv.bc0, a1 = gv.li1 - gv.bc1;
        const float cm = wave_scan_max(fmaxf(a0, a1), lane); const float cmprev = cummax_prev(cm);
        const float M0 = fmaxf(mp, fmaxf(cmprev, a0)), M1 = fmaxf(mp, cm);
        const int u0 = 2 * lane; const int s0 = dir ? 127 - u0 : u0, s1 = dir ? 126 - u0 : u0 + 1;
        LAS float* gb = gvv + dir * 512;
        gb[s0] = a0 * 1.44269504089f; gb[s1] = a1 * 1.44269504089f; gb[128 + s0] = M0 * 1.44269504089f; gb[128 + s1] = M1 * 1.44269504089f; gb[256 + s0] = __expf(mp - M0); gb[256 + s1] = __expf(mp - M1);
        gb[384 + s0] = __expf(-gv.bc0 - M0); gb[384 + s1] = __expf(-gv.bc1 - M1); }
#pragma unroll
    for (int i = 0; i < 2; ++i) { const int idx = tid + NTHR * i; const int s = idx >> 3, c8 = (idx & 7) * 8;
        *(LAS u32x4*)(Vs + s * 72 + c8) = P.v[i];
        *(LAS u32x4*)(Ks + s * 72 + c8) = P.k[i];
        const float* cw = F.in[I_CONVW] + l * 1536 + h * 64 + c8;
        f32x2 a[4]; float x[8];
#pragma unroll
        for (int q = 0; q < 4; ++q) a[q] = (f32x2){0.f, 0.f};
#pragma unroll
        for (int tap = 0; tap < 3; ++tap) { unpack8(P.q[i][tap], x); const f32x4 w0 = *(const f32x4*)(cw + tap * 512), w1 = *(const f32x4*)(cw + tap * 512 + 4);
            a[0] += (f32x2){x[0], x[1]} * (f32x2){w0[0], w0[1]}; a[1] += (f32x2){x[2], x[3]} * (f32x2){w0[2], w0[3]};
            a[2] += (f32x2){x[4], x[5]} * (f32x2){w1[0], w1[1]}; a[3] += (f32x2){x[6], x[7]} * (f32x2){w1[2], w1[3]}; }
        float k[8];
#pragma unroll
        for (int q = 0; q < 4; ++q) { const f32x2 r = fsilu2(a[q]); k[2 * q] = r.x; k[2 * q + 1] = r.y; }
        *(LAS bf16x8*)(Qs + s * 72 + c8) = pack8(k); }
#pragma unroll
    for (int i = 0; i < 4; ++i) { const int idx = tid + NTHR * i; const int dir = idx >> 10, e = (idx >> 4) & 63, d4 = (idx & 15) * 4;
        u32x2 o; o.x = pk2(P.ct[i][0], P.ct[i][1]); o.y = pk2(P.ct[i][2], P.ct[i][3]); *(LAS u32x2*)(CT + (dir * 64 + e) * 72 + d4) = o; }
    if (tid < 128) nv[tid] = P.nvv;
    __syncthreads();
    if (nx >= 0) ml_out_prefetch(F, l, nx, P);
    const int t = 16 * w + fr;
    f32x4 S[8];
#pragma unroll
    for (int nt = 0; nt < 8; ++nt) S[nt] = mma_nt<64>(Qs + 16 * w * 72, 72, Ks + 16 * nt * 72, 72, (f32x4){0.f, 0.f, 0.f, 0.f}, fr, fq);
    float qn0 = 0.f, qn1 = 0.f;
    { float q[16]; unpack8(*(const LAS u32x4*)(Qs + t * 72 + fq * 16), q); unpack8(*(const LAS u32x4*)(Qs + t * 72 + fq * 16 + 8), q + 8);
#pragma unroll
      for (int j = 0; j < 16; ++j) { qn0 += q[j] * nv[fq * 16 + j]; qn1 += q[j] * nv[64 + fq * 16 + j]; }
      qn0 += __shfl_xor(qn0, 16); qn0 += __shfl_xor(qn0, 32); qn1 += __shfl_xor(qn1, 16); qn1 += __shfl_xor(qn1, 32); }
    LAS bf16_t* Pw = Ps + w * 16 * 136;
    f32x4 hs[4];
#pragma unroll
    for (int n2 = 0; n2 < 4; ++n2) hs[n2] = (f32x4){0.f, 0.f, 0.f, 0.f};
#pragma unroll
    for (int dir = 0; dir < 2; ++dir) {
        const LAS float* gb = gvv + dir * 512;
        const float Mt = gb[128 + t], inter = gb[256 + t], em = gb[384 + t];
        float den = 0.f;
#pragma unroll
        for (int nt = 0; nt < 8; ++nt) { const bool full = dir ? (nt > w) : (nt < w); const bool diag = (nt == w);
            if (full || diag) { const f32x4 av = *(const LAS f32x4*)(gb + nt * 16 + 4 * fq); float p[4];
#pragma unroll
                for (int j = 0; j < 4; ++j) p[j] = S[nt][j] * __builtin_amdgcn_exp2f(av[j] - Mt);
                if (diag) {
#pragma unroll
                    for (int j = 0; j < 4; ++j) { const int si = nt * 16 + 4 * fq + j; const bool ok = dir ? (si >= t) : (si <= t); p[j] = ok ? p[j] : 0.f; } }
                den += (p[0] + p[1]) + (p[2] + p[3]);
                u32x2 pw; pw.x = pk2(p[0], p[1]); pw.y = pk2(p[2], p[3]); *(LAS u32x2*)(Pw + fr * 136 + nt * 16 + 4 * fq) = pw; }
            else if (nt == (w ^ 1)) *(LAS u32x2*)(Pw + fr * 136 + nt * 16 + 4 * fq) = (u32x2){0u, 0u}; }
        den += __shfl_xor(den, 16); den += __shfl_xor(den, 32);
        den += inter * (dir ? qn1 : qn0);
        const float rd = 1.f / fmaxf(fabsf(den), em);
        __builtin_amdgcn_wave_barrier();
        f32x4 acc[4];
#pragma unroll
        for (int n2 = 0; n2 < 4; ++n2) { acc[n2] = mma_nt<64>(Qs + 16 * w * 72, 72, CT + (dir * 64 + 16 * n2) * 72, 72, (f32x4){0.f, 0.f, 0.f, 0.f}, fr, fq); acc[n2] *= inter; }
#pragma unroll
        for (int c = 0; c < 4; ++c) { if (dir ? (c >= (w >> 1)) : (c <= (w >> 1))) {
            const bf16x8 pf = *(const LAS bf16x8*)(Pw + fr * 136 + 32 * c + 8 * fq);
#pragma unroll
            for (int n2 = 0; n2 < 4; ++n2) acc[n2] = __builtin_amdgcn_mfma_f32_16x16x32_bf16(tr_frag(Vs, 72, 32 * c, 16 * n2, lane), pf, acc[n2], 0, 0, 0); } }
#pragma unroll
        for (int n2 = 0; n2 < 4; ++n2) hs[n2] += acc[n2] * rd;
        __builtin_amdgcn_wave_barrier();
    }
    { float s = 0.f;
#pragma unroll
      for (int n2 = 0; n2 < 4; ++n2)
#pragma unroll
          for (int j = 0; j < 4; ++j) s += hs[n2][j];
      s += __shfl_xor(s, 16); s += __shfl_xor(s, 32); const float mu = s * (1.f / 64.f);
      float q = 0.f;
#pragma unroll
      for (int n2 = 0; n2 < 4; ++n2)
#pragma unroll
          for (int j = 0; j < 4; ++j) { hs[n2][j] -= mu; q += hs[n2][j] * hs[n2][j]; }
      q += __shfl_xor(q, 16); q += __shfl_xor(q, 32); const float rstd = rsqrtf(q * (1.f / 64.f) + EPS);
#pragma unroll
      for (int n2 = 0; n2 < 4; ++n2) { const int e0 = 16 * n2 + 4 * fq; const f32x4 ng = ngp[n2];
          float og[4]; unpack4(ogp[n2], og);
          float o[4];
#pragma unroll
          for (int j = 0; j < 4; ++j) o[j] = hs[n2][j] * rstd * ng[j] * fsigmoid(og[j]);
          u32x2 wv; wv.x = pk2(o[0], o[1]); wv.y = pk2(o[2], o[3]); *(u32x2*)(F.MIX + (size_t)(row0 + t) * D + 256 + h * 64 + e0) = wv; } }
    __syncthreads();
}


#define XB_TMO      128
#define XB_XCNT(j)  (256  + 64 * (j))
#define XB_XSUB(j)  (1280 + 64 * (j))
#define XB_XGEN(j)  (2304 + 64 * (j))
#define XB_TOP      3328
#define XB_TOPGEN   3392
#define XCD_BAR_WORDS 3456
#define XB_SPIN_CAP (1u << 22)
DEV unsigned xb_ld(unsigned* p)              { return __hip_atomic_load(p, __ATOMIC_RELAXED, __HIP_MEMORY_SCOPE_AGENT); }
DEV unsigned xb_add(unsigned* p, unsigned v) { return __hip_atomic_fetch_add(p, v, __ATOMIC_RELAXED, __HIP_MEMORY_SCOPE_AGENT); }
DEV unsigned xb_xcc_id() { return (unsigned)__builtin_amdgcn_s_getreg((3 << 11) | 20) & 0xFu; }
#define XB_SPIN(cond, bar) do { unsigned _sp = 0; while (cond) { __builtin_amdgcn_s_sleep(1); \
    if ((++_sp & 255u) == 0u) { if (xb_ld(&(bar)[XB_TMO])) break; if (_sp > XB_SPIN_CAP) { atomicAdd(&(bar)[XB_TMO], 1u); break; } } } } while (0)
struct XcdBarrier { unsigned* bar; unsigned x; volatile LAS unsigned* st; };
DEV XcdBarrier xcd_barrier_post(unsigned* bar, volatile LAS unsigned* st) {
    XcdBarrier b; b.bar = bar; b.x = xb_xcc_id(); b.st = st;
    if (threadIdx.x == 0) (void)xb_add(&bar[XB_XCNT(b.x)], 1u);
    return b;
}
DEV void xcd_barrier_complete(unsigned* bar, unsigned x, unsigned& nloc, unsigned& nx) {
    const unsigned G = gridDim.x * gridDim.y * gridDim.z;
    unsigned sum, cnt, mine, sp = 0u;
    for (;;) {
        sum = 0u; cnt = 0u; mine = 0u;
#pragma unroll
        for (unsigned j = 0; j < 16; ++j) { const unsigned c = xb_ld(&bar[XB_XCNT(j)]); sum += c; cnt += (c > 0u) ? 1u : 0u; mine = (j == x) ? c : mine; }
        if (sum == G) break;
        __builtin_amdgcn_s_sleep(1);
        if ((++sp & 255u) == 0u) { if (xb_ld(&bar[XB_TMO])) break; if (sp > XB_SPIN_CAP) { atomicAdd(&bar[XB_TMO], 1u); break; } }
    }
    nloc = mine > 0u ? mine : 1u; nx = cnt > 0u ? cnt : 1u;
}
DEV void xcd_barrier(const XcdBarrier& b) {
    asm volatile("s_waitcnt vmcnt(0)" ::: "memory");
    __syncthreads();
    if (threadIdx.x == 0) {
        unsigned* bar = b.bar;
        __builtin_amdgcn_s_waitcnt(0);
        unsigned nloc = b.st[0], nx = b.st[1];
        if (nloc == 0u) { xcd_barrier_complete(bar, b.x, nloc, nx); b.st[0] = nloc; b.st[1] = nx; }
        const unsigned old = xb_add(&bar[XB_XSUB(b.x)], 1u);
        const unsigned gen = old / nloc;
        if (old + 1u == (gen + 1u) * nloc) {
            __builtin_amdgcn_fence(__ATOMIC_RELEASE, "agent");
            asm volatile("s_waitcnt vmcnt(0)" ::: "memory");
            const unsigned og = xb_add(&bar[XB_TOP], 1u);
            const unsigned tg = og / nx;
            if (og + 1u == (tg + 1u) * nx) xb_add(&bar[XB_TOPGEN], 1u);
            else XB_SPIN(xb_ld(&bar[XB_TOPGEN]) == tg, bar);
            __builtin_amdgcn_fence(__ATOMIC_ACQUIRE, "agent");
            xb_add(&bar[XB_XGEN(b.x)], 1u);
            asm volatile("s_waitcnt vmcnt(0)" ::: "memory");
        } else {
            XB_SPIN(xb_ld(&bar[XB_XGEN(b.x)]) == gen, bar);
            __builtin_amdgcn_fence(__ATOMIC_ACQUIRE, "agent");
            asm volatile("s_waitcnt vmcnt(0)" ::: "memory");
        }
    }
    __syncthreads();
}

#define CG_LOOP(NCB, CALL) do { if (F.G == 256) { const int xcd_ = F.bid & 7; for (int it2 = F.bid >> 3; ; it2 += 32) { const int cb = xcd_ + 8 * (it2 >> 3); if (cb >= (NCB)) break; const int rb = it2 & 7; CALL; } } \
        else { for (int it = F.bid; it < 8 * (NCB); it += F.G) { const int rb = it / (NCB), cb = it % (NCB); CALL; } } } while (0)
#define RETID() do { int t_ = threadIdx.x; asm volatile("" : "+v"(t_)); F.tid = t_; F.lane = t_ & 63; F.wave = __builtin_amdgcn_readfirstlane(t_ >> 6); } while (0)
__global__ void __launch_bounds__(NTHR, 2) fwd_megakernel(Args args) {
    extern __shared__ __attribute__((aligned(16))) unsigned char lds_raw[];
    cg::grid_group grid = cg::this_grid();
    Fr F;
#pragma unroll
    for (int i = 0; i < 19; ++i) F.in[i] = args.in[i];
    F.out = args.out; F.ws = args.ws;
    F.A = (bf16_t*)(F.ws + WS_A); F.Y = (bf16_t*)(F.ws + WS_Z); F.XB = (bf16_t*)(F.ws + WS_Y);     F.Z = (bf16_t*)(F.ws + WS_Z); F.MIX = (bf16_t*)(F.ws + WS_MIX); F.H = (bf16_t*)(F.ws + WS_H);
    F.CL = (float*)(F.ws + WS_CL); F.NL = (float*)(F.ws + WS_NL); F.AL = (float*)(F.ws + WS_SC); F.BE = F.AL + 16 * NCH; F.MS = F.BE + 16 * NCH;
    F.MOD = (float*)(F.ws + WS_MOD); F.CTXR = (float*)(F.ws + WS_CTXR); F.ROPE = (float*)(F.ws + WS_ROPE);
    F.lds = (LAS unsigned char*)lds_raw;
    RETID(); F.G = gridDim.x; F.bid = blockIdx.x;
    volatile LAS unsigned* xst = (volatile LAS unsigned*)(F.lds + 131072);
    if (F.tid < 4) xst[F.tid] = 0u;
    __syncthreads();
    const XcdBarrier xbar = xcd_barrier_post((unsigned*)(F.ws + WS_BAR), xst);

    prologue_a(F);
    grid.sync(); RETID();
    { RowPass P{nullptr, F.in[I_X], F.in[I_CTX], false, nullptr, nullptr, F.in[I_NORMG], F.MOD, F.MOD + 1024, true, false}; rowpass<true>(F, P); }
    xcd_barrier(xbar); RETID();

    for (int l = 0; l < DEPTH; ++l) {
        const float* MODl = F.MOD + (size_t)l * 3 * 6144; const float* ng = F.in[I_NORMG] + l * 4 * D;
        { pg8::Gemm g{F.A, wt_ptr(F, l, 0), NB * SEQ, ZS, D}; pg8::StaticOrder S; S.init(NB * SEQ, ZS, F.G, F.bid); pg8::EpiBf16 E{F.Z, ZS}; pg8::gemm_phase(F.lds, F.tid, g, S, E); }
        RETID();
        CG_LOOP(37, cgemm_tile<0>(F, F.A, wt_ptr(F, l, 0), D, rb, cb, F.Z, ZS));
        xcd_barrier(xbar); RETID();
        for (int it = F.bid; it < 1040; it += F.G) ml_local_item(F, l, it / 520, (it >> 2) % NCH, it & 3);
        RETID();
        sgu_phase(F, l, (F.bid + 16 * F.G - 1040) % F.G);
        RETID();
        for (int it = (F.bid + 16 * F.G - 2080) % F.G; it < 8; it += F.G) { if (l + 1 == DEPTH) continue; attn_item(F, l, it >> 2, (it >> 1) & 1, it & 1, true); }
        xcd_barrier(xbar); RETID();
        ml_scan(F);
        RETID();
        { unsigned* qctr = (unsigned*)(F.ws + WS_BAR) + XCD_BAR_WORDS + 16 * l; volatile LAS unsigned* qs = (volatile LAS unsigned*)(F.lds + 131072 + 64);
          for (;;) { __syncthreads(); if (F.tid == 0) qs[0] = atomicAdd(qctr, 1u); __syncthreads(); const int it = (int)qs[0]; if (it >= 512 + 384) break;
              if (it < 512) attn_item(F, l, it >> 8, (it >> 1) & 127, it & 1, false);
              else pool_phase(F, l, it - 512, 4096); } }
        xcd_barrier(xbar); RETID();
        { int it = F.bid; while (it < 1040 && (l + 1 == DEPTH && (it >> 2) % NCH < 2)) it += F.G;
          if (it < 1040) { MoPre P; ml_out_prefetch(F, l, it, P);
              while (it < 1040) { int nx = it + F.G; while (nx < 1040 && (l + 1 == DEPTH && (nx >> 2) % NCH < 2)) nx += F.G;
                  ml_out_item(F, l, it, P, nx < 1040 ? nx : -1); it = nx; } } }
        RETID();
        if (F.bid >= 16) pool_phase(F, l, 384 + F.bid - 16, F.G - 16);
        xcd_barrier(xbar); RETID();
        { pg8::Gemm g{F.MIX, wt_ptr(F, l, 1), NB * SEQ, D, D}; pg8::StaticOrder S; S.init(NB * SEQ, D, F.G, F.bid); pg8::EpiBf16 E{F.Y, D}; pg8::gemm_phase(F.lds, F.tid, g, S, E); }
        RETID();
        if (l + 1 < DEPTH) CG_LOOP(16, cgemm_tile<0>(F, F.MIX, wt_ptr(F, l, 1), D, rb, cb, F.Y, D));
        xcd_barrier(xbar); RETID();
        { RowPass P{F.Y, F.in[I_X], F.in[I_CTX], false, MODl + 2048, ng + D, ng + 2 * D, MODl + 3072, MODl + 4096, true, l + 1 == DEPTH}; if (l == 0) rowpass<true>(F, P); else rowpass<false>(F, P); }
        xcd_barrier(xbar); RETID();
        { pg8::Gemm g{F.A, wt_ptr(F, l, 2), NB * SEQ, 2 * FH, D}; pg8::StaticOrder S; S.init(NB * SEQ, 2 * FH, F.G, F.bid); pg8::EpiSwiglu E{F.H}; pg8::gemm_phase(F.lds, F.tid, g, S, E); }
        RETID();
        if (l + 1 < DEPTH) CG_LOOP(88, cgemm_tile<1>(F, F.A, wt_ptr(F, l, 2), D, rb, cb, F.H, FH));
        xcd_barrier(xbar); RETID();
        { pg8::Gemm g{F.H, wt_ptr(F, l, 3), NB * SEQ, D, FH}; pg8::StaticOrder S; S.init(NB * SEQ, D, F.G, F.bid); pg8::EpiBf16 E{F.A, D}; pg8::gemm_phase(F.lds, F.tid, g, S, E); }
        RETID();
        if (l + 1 < DEPTH) CG_LOOP(16, cgemm_tile<0>(F, F.H, wt_ptr(F, l, 3), FH, rb, cb, F.A, D));
        xcd_barrier(xbar); RETID();
        { const bool lastl = (l == DEPTH - 1); const float* MODn = MODl + (lastl ? 0 : 3 * 6144); const float* ngn = ng + (lastl ? 0 : 4 * D);
          RowPass P{F.A, nullptr, nullptr, lastl, MODl + 5120, ng + 3 * D, ngn, MODn, MODn + 1024, !lastl, lastl}; rowpass<false>(F, P); }
        if (l + 1 < DEPTH) xcd_barrier(xbar); RETID();
    }
}

extern "C" void kernel_launch(void* const* d_in, const int* in_sizes, int n_in, void* d_out, int out_size, void* d_ws, size_t ws_size, hipStream_t stream) {
    static int grid = 0;
    if (grid == 0) {
        if (n_in != 19 || ws_size < WS_END) { fprintf(stderr, "kernel_launch: need 19 inputs and >= %zu bytes of workspace (got %d, %zu)\n", (size_t)WS_END, n_in, ws_size); grid = -1; return; }
        int dev = 0, cus = 0, per_cu = 0;
        hipGetDevice(&dev); hipDeviceGetAttribute(&cus, hipDeviceAttributeMultiprocessorCount, dev);
        if (hipFuncSetAttribute((const void*)fwd_megakernel, hipFuncAttributeMaxDynamicSharedMemorySize, LDS_BYTES) != hipSuccess) { fprintf(stderr, "kernel_launch: hipFuncSetAttribute failed\n"); grid = -1; return; }
        if (hipOccupancyMaxActiveBlocksPerMultiprocessor(&per_cu, (const void*)fwd_megakernel, NTHR, LDS_BYTES) != hipSuccess || per_cu < 1) { fprintf(stderr, "kernel_launch: occupancy query gives %d\n", per_cu); per_cu = 1; }
        (void)hipGetLastError();
        grid = cus;
    }
    if (grid < 0) return;
    if (hipMemsetAsync((char*)d_ws + WS_BAR, 0, 16384, stream) != hipSuccess) { fprintf(stderr, "kernel_launch: memset failed\n"); return; }
    Args a{};
    for (int i = 0; i < 19; ++i) a.in[i] = (const float*)d_in[i];
    a.out = (float*)d_out; a.ws = (unsigned char*)d_ws;
    void* kargs[] = {&a};
    hipError_t e = hipLaunchCooperativeKernel((const void*)fwd_megakernel, dim3(grid), dim3(NTHR), kargs, LDS_BYTES, stream);
    if (e != hipSuccess) fprintf(stderr, "cooperative launch failed: %s (grid %d)\n", hipGetErrorString(e), grid);
}
```

```cpp
#include <hip/hip_runtime.h>
#include <hip/hip_cooperative_groups.h>
#include <cstdio>
namespace cg = cooperative_groups;

#define LAS __attribute__((address_space(3)))
#define DEV __device__ __forceinline__
typedef unsigned short bf16_t;
typedef short bf16x8 __attribute__((ext_vector_type(8)));
typedef float f32x4 __attribute__((ext_vector_type(4)));
typedef unsigned u32x4 __attribute__((ext_vector_type(4)));
typedef unsigned u32x2 __attribute__((ext_vector_type(2)));

constexpr int D = 1024, NB = 2, SEQ = 16384, CTXL = 256, DEPTH = 4;
constexpr int RPB = SEQ + CTXL;
constexpr int MROWS = NB * RPB;
constexpr int NCH = RPB / 128;
constexpr int ZS = 2560;
constexpr int INC = 2320;
constexpr int FH = 2816;
constexpr int ZC_SGU = 0, ZC_MQ = 512, ZC_MK = 768, ZC_MV = 1024, ZC_MO = 1280, ZC_MG = 1536;
constexpr int ZC_AQ = 1552, ZC_AK = 1808, ZC_AV = 1936, ZC_POOL = 2064;
constexpr float EPS = 1e-6f;

constexpr size_t WS_A = 0;
constexpr size_t SZ_ACT = (size_t)MROWS * D * 2;
constexpr size_t WS_Y = WS_A + SZ_ACT;
constexpr size_t WS_Z = WS_Y + SZ_ACT;
constexpr size_t WS_MIX = WS_Z + (size_t)MROWS * ZS * 2;
constexpr size_t WS_H = WS_Z;
constexpr size_t WS_W = WS_MIX + SZ_ACT;
constexpr size_t SZ_WIN = (size_t)ZS * D * 2, SZ_WOUT = (size_t)D * D * 2, SZ_WFI = (size_t)2 * FH * D * 2, SZ_WFO = (size_t)D * FH * 2;
constexpr size_t SZ_WL = SZ_WIN + SZ_WOUT + SZ_WFI + SZ_WFO;
constexpr size_t WS_CL = WS_W + DEPTH * SZ_WL;
constexpr size_t WS_NL = WS_CL + (size_t)16 * NCH * 4096 * 4;
constexpr size_t WS_SC = WS_NL + (size_t)16 * NCH * 64 * 4;
constexpr size_t WS_MOD = WS_SC + 32768;
constexpr size_t WS_CTXR = WS_MOD + (size_t)DEPTH * 3 * 6144 * 4;
constexpr size_t WS_ROPE = WS_CTXR + (size_t)NB * CTXL * D * 4;
constexpr size_t WS_BAR = WS_ROPE + 40960;
constexpr size_t WS_END = WS_BAR + 16384;
static_assert(WS_H + (size_t)MROWS * FH * 2 <= WS_W, "H alias");

constexpr int NTHR = 512;
constexpr int LDS_BYTES = 135168;

DEV unsigned f2bf(float f) { unsigned u = __builtin_bit_cast(unsigned, f); return (u + 0x7fffu + ((u >> 16) & 1u)) >> 16; }
DEV unsigned pk2(float lo, float hi) { unsigned r; asm("v_cvt_pk_bf16_f32 %0, %1, %2" : "=v"(r) : "v"(lo), "v"(hi)); return r; }
DEV float bf2f(unsigned v) { return __builtin_bit_cast(float, v << 16); }
DEV void unpack8(u32x4 v, float* o) {
#pragma unroll
    for (int i = 0; i < 4; ++i) { o[2 * i] = bf2f(v[i] & 0xffffu); o[2 * i + 1] = __builtin_bit_cast(float, v[i] & 0xffff0000u); }
}
DEV void unpack4(u32x2 v, float* o) {
#pragma unroll
    for (int i = 0; i < 2; ++i) { o[2 * i] = bf2f(v[i] & 0xffffu); o[2 * i + 1] = __builtin_bit_cast(float, v[i] & 0xffff0000u); }
}
DEV float fsigmoid(float x) { return __builtin_amdgcn_rcpf(1.f + __expf(-x)); }
DEV float fsilu(float x) { return x * fsigmoid(x); }
DEV float fgelu(float x) { const float y = 0.7978845608f * (x + 0.044715f * x * x * x); const float t = 1.f - 2.f * __builtin_amdgcn_rcpf(__expf(2.f * y) + 1.f); return 0.5f * x * (1.f + t); }
DEV float logsigmoid(float x) { return fminf(x, 0.f) - log1pf(__expf(-fabsf(x))); }
#define DPPF(idbits, v, ctrl, rmask) __builtin_bit_cast(float, __builtin_amdgcn_update_dpp((int)(idbits), __builtin_bit_cast(int, (v)), (ctrl), (rmask), 0xf, false))
DEV float red4_add(float v) { v += __shfl_xor(v, 16); v += __shfl_xor(v, 32); return v; }
DEV float red4_max(float v) { v = fmaxf(v, __shfl_xor(v, 16)); v = fmaxf(v, __shfl_xor(v, 32)); return v; }
DEV float wave_sum(float v) {
    v += DPPF(0, v, 0x128, 0xf); v += DPPF(0, v, 0x124, 0xf); v += DPPF(0, v, 0x122, 0xf); v += DPPF(0, v, 0x121, 0xf);
    return red4_add(v);
}
DEV float wave_max(float v) {
    v = fmaxf(v, DPPF(0xff800000u, v, 0x128, 0xf)); v = fmaxf(v, DPPF(0xff800000u, v, 0x124, 0xf)); v = fmaxf(v, DPPF(0xff800000u, v, 0x122, 0xf)); v = fmaxf(v, DPPF(0xff800000u, v, 0x121, 0xf));
    return red4_max(v);
}
DEV float wave_scan_add(float v, int lane) {
    (void)lane;
    v += DPPF(0, v, 0x111, 0xf); v += DPPF(0, v, 0x112, 0xf); v += DPPF(0, v, 0x114, 0xf); v += DPPF(0, v, 0x118, 0xf);
    v += DPPF(0, v, 0x142, 0xa); v += DPPF(0, v, 0x143, 0xc);
    return v;
}
DEV float wave_scan_max(float v, int lane) {
    (void)lane;
    v = fmaxf(v, DPPF(0xff800000u, v, 0x111, 0xf)); v = fmaxf(v, DPPF(0xff800000u, v, 0x112, 0xf)); v = fmaxf(v, DPPF(0xff800000u, v, 0x114, 0xf)); v = fmaxf(v, DPPF(0xff800000u, v, 0x118, 0xf));
    v = fmaxf(v, DPPF(0xff800000u, v, 0x142, 0xa)); v = fmaxf(v, DPPF(0xff800000u, v, 0x143, 0xc));
    return v;
}
DEV float cummax_prev(float cm) { return fmaxf(DPPF(0xff800000u, cm, 0x111, 0xf), DPPF(0xff800000u, cm, 0x142, 0xe)); }
typedef short v4s __attribute__((ext_vector_type(4)));
DEV bf16x8 tr_frag(const LAS bf16_t* T, int ld, int k0, int n0, int lane) {
    const int g = lane >> 4, q = (lane & 15) >> 2, p = lane & 3;
    const LAS bf16_t* a0 = T + (k0 + 8 * g + q) * ld + n0 + 4 * p;
    const v4s lo = __builtin_amdgcn_ds_read_tr16_b64_v4i16((LAS v4s*)a0), hi = __builtin_amdgcn_ds_read_tr16_b64_v4i16((LAS v4s*)(a0 + 4 * ld));
    return __builtin_shufflevector(lo, hi, 0, 1, 2, 3, 4, 5, 6, 7);
}
template <int K>
DEV f32x4 mma_nt(const LAS bf16_t* X, int ldx, const LAS bf16_t* Y, int ldy, f32x4 acc, int fr, int fq) {
#pragma unroll
    for (int k0 = 0; k0 < K; k0 += 32) {
        const bf16x8 xf = *(const LAS bf16x8*)(X + fr * ldx + k0 + fq * 8);
        const bf16x8 yf = *(const LAS bf16x8*)(Y + fr * ldy + k0 + fq * 8);
        acc = __builtin_amdgcn_mfma_f32_16x16x32_bf16(yf, xf, acc, 0, 0, 0);
    }
    return acc;
}

namespace pg8 {
constexpr int BM = 256, BK = 64, HALF = 128, HTB = HALF * BK * 2, STAGE_BYTES = 8 * HTB, NXCD = 8, WGM = 8;
DEV int lds_byte(int r, int c) { const int st = (r >> 4) * 2 + (c >> 5), rr = r & 15, cc = c & 31, ob = rr * 64 + cc * 2; return st * 1024 + (ob ^ (((ob >> 9) & 1) << 5)); }
DEV void stage_rc(int b, int& R, int& C) { const int st = b / 1024, sb = b % 1024, swz = sb ^ (((sb >> 9) & 1) << 5); R = (st >> 1) * 16 + swz / 64; C = (st & 1) * 32 + (swz % 64) / 2; }
DEV int perm32(int rho) { const int n = rho >> 4, i = rho & 15; return 8 * (i >> 2) + 4 * n + (i & 3); }
struct Unit { int pm, pn; };
DEV int prow(int pm) { return pm * 256 + 256 + ((pm >> 6) << 8); }
struct Gemm { const bf16_t* A; const bf16_t* Bt; int M, N, K; };
struct StaticOrder {
    int nM, nN, nwg, G, c, px, xq, rk;
    DEV void init(int M, int N, int G_, int c_) { nM = M / BM; nN = N / BM; nwg = nM * nN; G = G_; c = c_; px = 0; xq = 0; rk = 0; }
    DEV void part(int px_, int xq_, int rk_) { px = px_; xq = xq_; rk = rk_; }
    DEV bool next(int i, Unit& u) const {
        if (px) { const int j = i * 32 + rk; if (j >= 16 * nN) return false; const int g4 = j / (4 * nN), t = j - g4 * 4 * nN; u.pm = 16 * xq + 4 * g4 + (t & 3); u.pn = t >> 2; return true; }
        const long L = (long)i * G + c; if (L >= nwg) return false;
        int wgid = (int)L; { const int q = nwg / NXCD, r = nwg % NXCD, xcd = wgid % NXCD, off = wgid / NXCD; wgid = (xcd < r ? xcd * (q + 1) : r * (q + 1) + (xcd - r) * q) + off; }
        const int nig = WGM * nN, gid = wgid / nig, fm = gid * WGM, gsz = (nM - fm) < WGM ? (nM - fm) : WGM;
        u.pm = fm + ((wgid % nig) % gsz); u.pn = (wgid % nig) / gsz; return true;
    }
};
DEV unsigned cvt_pk_bf16(float lo, float hi) { unsigned r; asm volatile("v_cvt_pk_bf16_f32 %0, %1, %2" : "=v"(r) : "v"(lo), "v"(hi)); return r; }
struct EpiBf16 {
    bf16_t* O; int ldc;
    DEV void operator()(const f32x4 (&acc)[2][2][4][2], const Unit& u, int wr, int wc, int fr, int fq) const {
        const int row0 = prow(u.pm) + wr * 64 + fr; const int col0 = u.pn * BM + wc * 32 + 8 * fq;
#pragma unroll
        for (int ai = 0; ai < 2; ++ai)
#pragma unroll
            for (int m = 0; m < 4; ++m) { bf16_t* rowp = O + (size_t)(row0 + ai * HALF + m * 16) * ldc + col0;
#pragma unroll
                for (int bj = 0; bj < 2; ++bj) { const f32x4 v0 = acc[ai][bj][m][0], v1 = acc[ai][bj][m][1];
                    u32x4 w; w.x = cvt_pk_bf16(v0[0], v0[1]); w.y = cvt_pk_bf16(v0[2], v0[3]); w.z = cvt_pk_bf16(v1[0], v1[1]); w.w = cvt_pk_bf16(v1[2], v1[3]);
                    *(u32x4*)(rowp + bj * HALF) = w; } }
    }
};
struct EpiSwiglu {
    bf16_t* O;
    DEV void operator()(const f32x4 (&acc)[2][2][4][2], const Unit& u, int wr, int wc, int fr, int fq) const {
        const int row0 = prow(u.pm) + wr * 64 + fr; const int col0 = u.pn * HALF + wc * 32 + 8 * fq;
#pragma unroll
        for (int ai = 0; ai < 2; ++ai)
#pragma unroll
            for (int m = 0; m < 4; ++m) { bf16_t* rowp = O + (size_t)(row0 + ai * HALF + m * 16) * FH + col0;
                typedef float f32x2 __attribute__((ext_vector_type(2)));
                f32x2 gv[4], uv[4], ev[4], ov[4];
#pragma unroll
                for (int q = 0; q < 4; ++q) { const int n = q >> 1, j = (q & 1) * 2; gv[q] = (f32x2){acc[ai][0][m][n][j], acc[ai][0][m][n][j + 1]}; uv[q] = (f32x2){acc[ai][1][m][n][j], acc[ai][1][m][n][j + 1]}; }
#pragma unroll
                for (int q = 0; q < 4; ++q) { const f32x2 t = gv[q] * -1.44269504089f; ev[q].x = __builtin_amdgcn_exp2f(t.x); ev[q].y = __builtin_amdgcn_exp2f(t.y); }
#pragma unroll
                for (int q = 0; q < 4; ++q) { const f32x2 d = ev[q] + 1.0f; f32x2 r; r.x = __builtin_amdgcn_rcpf(d.x); r.y = __builtin_amdgcn_rcpf(d.y); ov[q] = (gv[q] * r) * uv[q]; }
                float o[8];
#pragma unroll
                for (int q = 0; q < 4; ++q) { o[2 * q] = ov[q].x; o[2 * q + 1] = ov[q].y; }
                u32x4 w; w.x = cvt_pk_bf16(o[0], o[1]); w.y = cvt_pk_bf16(o[2], o[3]); w.z = cvt_pk_bf16(o[4], o[5]); w.w = cvt_pk_bf16(o[6], o[7]);
                *(u32x4*)rowp = w; }
    }
};

template <class Epi>
DEV void gemm_phase(LAS unsigned char* lds, const int tid, const Gemm g, const StaticOrder& S, const Epi& E) {
    const int wid = __builtin_amdgcn_readfirstlane(tid >> 6), lane = tid & 63, wr = wid >> 2, wc = wid & 3, fr = lane & 15, fq = lane >> 4;
    const int K = g.K, nt = K / BK;
    unsigned voffA[2], voffB[2];
#pragma unroll
    for (int i = 0; i < 2; ++i) { int R, C; stage_rc(tid * 16 + i * 8192, R, C); const int Rb = (R & ~31) + perm32(R & 31);
        voffA[i] = (unsigned)(R * K + C) * 2u; voffB[i] = (unsigned)(Rb * K + C) * 2u; }
    const size_t kstep = (size_t)(BK * 2);
    const size_t hstep = (size_t)HALF * K * 2;
    const size_t tstep = 2 * hstep;
    const unsigned ldsw = (unsigned)wid * 1024u;
    const int aoff = lds_byte(wr * 64 + fr, fq * 8), boff = lds_byte(wc * 32 + fr, fq * 8);
#define PG8_SA(b, h) (((b) * 2 + (h)) * HTB)
#define PG8_SB(b, h) ((4 + (b) * 2 + (h)) * HTB)
#define PG8_STAGE(bufoff, gbase, voff) do { _Pragma("unroll") for (int _i = 0; _i < 2; ++_i) \
        __builtin_amdgcn_global_load_lds((const unsigned*)((const char*)(gbase) + (voff)[_i]), (LAS unsigned*)(lds + (bufoff) + ldsw + _i * 8192), 16, 0, 0); } while (0)
#define PG8_LDA(dst, b, h) do { _Pragma("unroll") for (int m = 0; m < 4; ++m) _Pragma("unroll") for (int k = 0; k < 2; ++k) dst[m][k] = *(const LAS bf16x8*)(lds + PG8_SA(b, h) + aoff + m * 2048 + k * 1024); } while (0)
#define PG8_LDB(dst, b, h) do { _Pragma("unroll") for (int n = 0; n < 2; ++n) _Pragma("unroll") for (int k = 0; k < 2; ++k) dst[n][k] = *(const LAS bf16x8*)(lds + PG8_SB(b, h) + boff + n * 2048 + k * 1024); } while (0)
#define PG8_MMA(ai, bj, At, Bt) do { __builtin_amdgcn_s_setprio(1); _Pragma("unroll") for (int m = 0; m < 4; ++m) _Pragma("unroll") for (int n = 0; n < 2; ++n) _Pragma("unroll") for (int k = 0; k < 2; ++k) \
        acc[ai][bj][m][n] = __builtin_amdgcn_mfma_f32_16x16x32_bf16(Bt[n][k], At[m][k], acc[ai][bj][m][n], 0, 0, 0); __builtin_amdgcn_s_setprio(0); } while (0)
#define PG8_WAIT_V(n) asm volatile("s_waitcnt vmcnt(" #n ")" ::: "memory")
#define PG8_WAIT_L(n) asm volatile("s_waitcnt lgkmcnt(" #n ")" ::: "memory")
#define PG8_BAR __builtin_amdgcn_s_barrier()
#define PG8_SCHED __builtin_amdgcn_sched_barrier(0)
    Unit cur, nxt; int ui = 0;
    if (!S.next(0, cur)) return;
    f32x4 acc[2][2][4][2];
#pragma unroll
    for (int a = 0; a < 2; ++a)
#pragma unroll
        for (int b = 0; b < 2; ++b)
#pragma unroll
            for (int m = 0; m < 4; ++m)
#pragma unroll
                for (int n = 0; n < 2; ++n) acc[a][b][m][n] = (f32x4){0.f, 0.f, 0.f, 0.f};
    bf16x8 At[4][2], B0[2][2], B1[2][2];
    const char* cA = (const char*)g.A + (size_t)prow(cur.pm) * K * 2; const char* cB = (const char*)g.Bt + (size_t)cur.pn * tstep;
    PG8_STAGE(PG8_SB(0, 0), cB, voffB); PG8_STAGE(PG8_SA(0, 0), cA, voffA); PG8_STAGE(PG8_SB(0, 1), cB + hstep, voffB); PG8_STAGE(PG8_SA(0, 1), cA + hstep, voffA);
    if (wr == 1) PG8_BAR;
    PG8_WAIT_V(4); PG8_BAR;
    PG8_STAGE(PG8_SB(1, 0), cB + kstep, voffB); PG8_STAGE(PG8_SA(1, 0), cA + kstep, voffA); PG8_STAGE(PG8_SB(1, 1), cB + hstep + kstep, voffB);
    PG8_WAIT_V(6); PG8_BAR;
    for (;;) {
        const bool has_next = S.next(ui + 1, nxt);
        const char* nA = has_next ? (const char*)g.A + (size_t)prow(nxt.pm) * K * 2 : cA; const char* nB = has_next ? (const char*)g.Bt + (size_t)nxt.pn * tstep : cB;
        for (int t = 0; t < nt; t += 2) {
            const bool last = (t == nt - 2);
            const char* a1 = cA + (size_t)(t + 1) * kstep;
            const char* a2 = last ? nA : cA + (size_t)(t + 2) * kstep; const char* b2 = last ? nB : cB + (size_t)(t + 2) * kstep;
            const char* a3 = a2 + kstep; const char* b3 = b2 + kstep;
            PG8_LDB(B0, 0, 0); PG8_SCHED; PG8_LDA(At, 0, 0); PG8_STAGE(PG8_SA(1, 1), a1 + hstep, voffA);
            PG8_WAIT_L(8); PG8_BAR; PG8_WAIT_L(0); PG8_MMA(0, 0, At, B0); PG8_BAR; PG8_SCHED;
            PG8_LDB(B1, 0, 1); PG8_STAGE(PG8_SB(0, 0), b2, voffB);
            PG8_BAR; PG8_WAIT_L(0); PG8_MMA(0, 1, At, B1); PG8_BAR;
            PG8_LDA(At, 0, 1); PG8_STAGE(PG8_SA(0, 0), a2, voffA);
            PG8_BAR; PG8_WAIT_L(0); PG8_MMA(1, 0, At, B0); PG8_BAR; PG8_SCHED;
            PG8_STAGE(PG8_SB(0, 1), b2 + hstep, voffB);
            PG8_WAIT_V(6); PG8_BAR; PG8_MMA(1, 1, At, B1); PG8_BAR;
            PG8_LDB(B0, 1, 0); PG8_SCHED; PG8_LDA(At, 1, 0); PG8_STAGE(PG8_SA(0, 1), a2 + hstep, voffA);
            PG8_WAIT_L(8); PG8_BAR; PG8_WAIT_L(0); PG8_MMA(0, 0, At, B0); PG8_BAR; PG8_SCHED;
            PG8_LDB(B1, 1, 1); PG8_STAGE(PG8_SB(1, 0), b3, voffB);
            PG8_BAR; PG8_WAIT_L(0); PG8_MMA(0, 1, At, B1); PG8_BAR;
            PG8_LDA(At, 1, 1); PG8_STAGE(PG8_SA(1, 0), a3, voffA);
            PG8_BAR; PG8_WAIT_L(0); PG8_MMA(1, 0, At, B0); PG8_BAR; PG8_SCHED;
            PG8_STAGE(PG8_SB(1, 1), b3 + hstep, voffB);
            PG8_WAIT_V(6); PG8_BAR; PG8_MMA(1, 1, At, B1); PG8_BAR;
        }
        E(acc, cur, wr, wc, fr, fq);
        if (!has_next) break;
#pragma unroll
        for (int a = 0; a < 2; ++a)
#pragma unroll
            for (int b = 0; b < 2; ++b)
#pragma unroll
                for (int m = 0; m < 4; ++m)
#pragma unroll
                    for (int n = 0; n < 2; ++n) acc[a][b][m][n] = (f32x4){0.f, 0.f, 0.f, 0.f};
        cur = nxt; cA = nA; cB = nB; ++ui;
    }
    PG8_WAIT_V(0);
    if (wr == 0) PG8_BAR;
    PG8_BAR;
#undef PG8_SA
#undef PG8_SB
#undef PG8_STAGE
#undef PG8_LDA
#undef PG8_LDB
#undef PG8_MMA
#undef PG8_WAIT_V
#undef PG8_WAIT_L
#undef PG8_BAR
#undef PG8_SCHED
}
}

struct Args { const float* in[19]; float* out; unsigned char* ws; };
struct Fr {
    const float* in[19]; float* out; unsigned char* ws;
    bf16_t *A, *Y, *Z, *MIX, *H, *XB; float *CL, *NL, *AL, *BE, *MS, *MOD, *CTXR; float* ROPE;
    LAS unsigned char* lds;
    int tid, lane, wave, G, bid;
    int px, xq, rk;
};
enum { I_X = 0, I_C, I_CTX, I_CCTX, I_WMOD, I_BMOD, I_NORMG, I_WIN, I_WOUT, I_SGUW, I_SGUB, I_CONVW, I_GATEB, I_MNORMG, I_SINK, I_POOLW, I_POOLS, I_WFI, I_WFO };

DEV bf16_t* wt_ptr(const Fr& F, int l, int which) {
    size_t off = WS_W + (size_t)l * SZ_WL;
    if (which >= 1) off += SZ_WIN; if (which >= 2) off += SZ_WOUT; if (which >= 3) off += SZ_WFI;
    return (bf16_t*)(F.ws + off);
}


template <int CH>
DEV void cg_chunk(f32x4 (&acc)[4][4], const bf16_t* ap, const bf16_t* bp, const int (&brow)[4], int K) {
    bf16x8 a[CH][4], b[CH][4];
#pragma unroll
    for (int c = 0; c < CH; ++c)
#pragma unroll
        for (int i = 0; i < 4; ++i) { a[c][i] = *(const bf16x8*)(ap + (size_t)(16 * i) * K + 32 * c); b[c][i] = *(const bf16x8*)(bp + (size_t)brow[i] * K + 32 * c); }
#pragma unroll
    for (int c = 0; c < CH; ++c)
#pragma unroll
        for (int mi = 0; mi < 4; ++mi)
#pragma unroll
            for (int ni = 0; ni < 4; ++ni) acc[mi][ni] = __builtin_amdgcn_mfma_f32_16x16x32_bf16(b[c][ni], a[c][mi], acc[mi][ni], 0, 0, 0);
}
template <int MODE>
DEV void cgemm_tile(const Fr& F, const bf16_t* A, const bf16_t* Bt, int K, int rb, int cb, bf16_t* O, int ldc) {
    LAS float* part = (LAS float*)F.lds;
    const int w = F.wave, fr = F.lane & 15, fq = F.lane >> 4;
    const int arow0 = (rb >> 2) * RPB + (rb & 3) * 64;
    int brow[4];
#pragma unroll
    for (int ni = 0; ni < 4; ++ni) {
        if (MODE == 0) brow[ni] = cb * 64 + ni * 16;
        else { const int j = cb * 32 + (ni & 1) * 16; brow[ni] = (j >> 7) * 256 + (ni >> 1) * 128 + (j & 127); }
    }
    const int kslice = K >> 3, steps = kslice >> 5;
    const bf16_t* ap = A + (size_t)(arow0 + fr) * K + w * kslice + 8 * fq;
    const bf16_t* bp = Bt + (size_t)fr * K + w * kslice + 8 * fq;
    f32x4 acc[4][4];
#pragma unroll
    for (int mi = 0; mi < 4; ++mi)
#pragma unroll
        for (int ni = 0; ni < 4; ++ni) acc[mi][ni] = (f32x4){0.f, 0.f, 0.f, 0.f};
    int s = 0;
    for (; s + 4 <= steps; s += 4) cg_chunk<4>(acc, ap + s * 32, bp + s * 32, brow, K);
    if (steps - s == 3) cg_chunk<3>(acc, ap + s * 32, bp + s * 32, brow, K);
    else if (steps - s == 2) cg_chunk<2>(acc, ap + s * 32, bp + s * 32, brow, K);
    else if (steps - s == 1) cg_chunk<1>(acc, ap + s * 32, bp + s * 32, brow, K);
#pragma unroll
    for (int mi = 0; mi < 4; ++mi)
#pragma unroll
        for (int ni = 0; ni < 4; ++ni) *(LAS f32x4*)(part + (w * 64 + 16 * mi + fr) * 64 + ((16 * ni + 4 * fq) ^ (fr << 2))) = acc[mi][ni];
    __syncthreads();
    { const int row = F.tid >> 3, c8 = (F.tid & 7) * 8, sw = (row & 15) << 2;
      if (MODE == 0) {
          f32x4 s0 = (f32x4){0.f, 0.f, 0.f, 0.f}, s1 = s0;
#pragma unroll
          for (int ww = 0; ww < 8; ++ww) { s0 += *(const LAS f32x4*)(part + (ww * 64 + row) * 64 + (c8 ^ sw)); s1 += *(const LAS f32x4*)(part + (ww * 64 + row) * 64 + ((c8 + 4) ^ sw)); }
          u32x4 o; o.x = pk2(s0[0], s0[1]); o.y = pk2(s0[2], s0[3]); o.z = pk2(s1[0], s1[1]); o.w = pk2(s1[2], s1[3]);
          *(u32x4*)(O + (size_t)(arow0 + row) * ldc + cb * 64 + c8) = o;
      } else if (c8 < 32) {
          f32x4 g0 = (f32x4){0.f, 0.f, 0.f, 0.f}, g1 = g0, u0 = g0, u1 = g0;
#pragma unroll
          for (int ww = 0; ww < 8; ++ww) { const LAS float* pr = part + (ww * 64 + row) * 64;
              g0 += *(const LAS f32x4*)(pr + (c8 ^ sw)); g1 += *(const LAS f32x4*)(pr + ((c8 + 4) ^ sw)); u0 += *(const LAS f32x4*)(pr + ((c8 + 32) ^ sw)); u1 += *(const LAS f32x4*)(pr + ((c8 + 36) ^ sw)); }
          float o[8];
#pragma unroll
          for (int j = 0; j < 4; ++j) { o[j] = fsilu(g0[j]) * u0[j]; o[4 + j] = fsilu(g1[j]) * u1[j]; }
          u32x4 ov; ov.x = pk2(o[0], o[1]); ov.y = pk2(o[2], o[3]); ov.z = pk2(o[4], o[5]); ov.w = pk2(o[6], o[7]);
          *(u32x4*)(O + (size_t)(arow0 + row) * ldc + cb * 32 + c8) = ov;
      } }
    __syncthreads();
}

DEV void wt_tile(const Fr& F, const float* src, int src_ld, int ncols_valid, int srccol0, int kt, bf16_t* dst, int K, int p0) {
    LAS float* tile = (LAS float*)F.lds;
    const int t = F.tid;
#pragma unroll
    for (int ps = 0; ps < 2; ++ps) {
        const int kk = (t >> 4) + 32 * ps, c4 = (t & 15) * 4;
        f32x4 v = (f32x4){0.f, 0.f, 0.f, 0.f};
        if (srccol0 + c4 < ncols_valid) v = *(const f32x4*)(src + (size_t)(kt * 64 + kk) * src_ld + srccol0 + c4);
#pragma unroll
        for (int i = 0; i < 4; ++i) tile[kk * 65 + c4 + i] = v[i];
    }
    __syncthreads();
    { const int p = t >> 3, ks = (t & 7) * 8; float o[8];
#pragma unroll
      for (int i = 0; i < 8; ++i) o[i] = tile[(ks + i) * 65 + p];
      u32x4 w; w.x = pk2(o[0], o[1]); w.y = pk2(o[2], o[3]); w.z = pk2(o[4], o[5]); w.w = pk2(o[6], o[7]);
      *(u32x4*)(dst + (size_t)(p0 + p) * K + kt * 64 + ks) = w; }
    __syncthreads();
}

DEV void prologue_a(const Fr& F) {
    constexpr int T_IN = 40 * 16, T_OUT = 16 * 16, T_FI = 88 * 16, T_FO = 16 * 44, T_L = T_IN + T_OUT + T_FI + T_FO;
    for (int idx = F.bid; idx < DEPTH * T_L; idx += F.G) {
        const int l = idx / T_L; int rem = idx % T_L;
        if (rem < T_IN) { const int pt = rem / 16, kt = rem % 16; wt_tile(F, F.in[I_WIN] + (size_t)l * D * INC, INC, INC, pt * 64, kt, wt_ptr(F, l, 0), D, pt * 64); continue; }
        rem -= T_IN;
        if (rem < T_OUT) { const int pt = rem / 16, kt = rem % 16; wt_tile(F, F.in[I_WOUT] + (size_t)l * D * D, D, D, pt * 64, kt, wt_ptr(F, l, 1), D, pt * 64); continue; }
        rem -= T_OUT;
        if (rem < T_FI) { const int pt = rem / 16, kt = rem % 16; const int p0 = pt * 64, unit = p0 >> 8, within = p0 & 255;
            const int sc0 = within < 128 ? unit * 128 + within : FH + unit * 128 + within - 128;
            wt_tile(F, F.in[I_WFI] + (size_t)l * D * 2 * FH, 2 * FH, 2 * FH, sc0, kt, wt_ptr(F, l, 2), D, p0); continue; }
        rem -= T_FI;
        { const int pt = rem / 44, kt = rem % 44; wt_tile(F, F.in[I_WFO] + (size_t)l * FH * D, D, D, pt * 64, kt, wt_ptr(F, l, 3), FH, pt * 64); }
    }
    {
        LAS float* sv = (LAS float*)F.lds;
        LAS float* red = sv + 3 * 1024;
        for (int i = F.tid; i < 3 * 1024; i += NTHR) { const int v = i >> 10, k = i & 1023; const float c = v < 2 ? F.in[I_C][v * 1024 + k] : F.in[I_CCTX][k]; sv[i] = fsilu(c); }
        __syncthreads();
        for (int idx = F.bid; idx < DEPTH * 96; idx += F.G) {
            const int l = idx / 96, cg_ = idx % 96; const int col = cg_ * 64 + F.lane, ks = F.wave;
            const float* wp = F.in[I_WMOD] + (size_t)l * D * 6144 + (size_t)(ks * 128) * 6144 + col;
            float a0 = 0.f, a1 = 0.f, a2 = 0.f;
#pragma unroll 8
            for (int k = 0; k < 128; ++k) { const float w = wp[(size_t)k * 6144]; const int kk = ks * 128 + k; a0 += sv[kk] * w; a1 += sv[1024 + kk] * w; a2 += sv[2048 + kk] * w; }
            red[(ks * 3 + 0) * 64 + F.lane] = a0; red[(ks * 3 + 1) * 64 + F.lane] = a1; red[(ks * 3 + 2) * 64 + F.lane] = a2;
            __syncthreads();
            if (F.tid < 192) { const int v = F.tid >> 6, cc = F.tid & 63; float s = 0.f;
#pragma unroll
                for (int w = 0; w < 8; ++w) s += red[(w * 3 + v) * 64 + cc];
                const int c2 = cg_ * 64 + cc; F.MOD[((size_t)l * 3 + v) * 6144 + c2] = s + F.in[I_BMOD][l * 6144 + c2]; }
            __syncthreads();
        }
    }
    for (int i = F.bid * NTHR + F.tid; i < 256 * 16; i += F.G * NTHR) {
        const int pos = i >> 4, fi = i & 15; const float inv = powf(10000.f, -(float)fi * 2.0f / 32.0f); const float ang = (float)pos * inv;
        float s, c; sincosf(ang, &s, &c); F.ROPE[2 * i] = c; F.ROPE[2 * i + 1] = s;
    }
}

struct RowPass { const bf16_t* Y; const float* xs_lat; const float* xs_ctx; bool out_f32; const float* gate; const float* gy; const float* gn; const float* sh; const float* sc; bool writeA; bool skip_ctx; };
template <bool SRCF32>
DEV void rowpass(const Fr& F, const RowPass& P) {
    const int c0 = F.lane * 4;
  for (int seg = 0; seg < (F.px ? 2 : 1); ++seg) {
    int rb, re;
    if (!F.px) { const int gw = F.bid * 8 + F.wave, nw = F.G * 8; rb = (int)(((long)gw * MROWS) / nw); re = (int)(((long)(gw + 1) * MROWS) / nw); }
    else if (seg == 0) { rb = pg8::prow(16 * F.xq) + 128 * F.rk + 16 * F.wave; re = rb + 16; }
    else { rb = (F.xq >> 2) * RPB + (F.xq & 3) * 64 + 2 * F.rk + F.wave; re = (F.wave < 2) ? rb + 1 : rb; }

    int curv = -1;
    f32x4 gg[4], gs[4], shv[4];
#pragma unroll
    for (int q = 0; q < 4; ++q) { gg[q] = (f32x4){0.f, 0.f, 0.f, 0.f}; gs[q] = gg[q]; shv[q] = gg[q]; }
    f32x4 xc[4], xn[4], xl[4]; u32x2 yc[4], yn[4], yl[4], bc[4], bn[4], bl[4];
#define RP_LOAD(r_, x_, y_, b_x) do { \
        if (SRCF32) { const int b_ = (r_) / RPB, p_ = (r_) % RPB; const bool ic_ = p_ < CTXL; \
            const float* sp_ = ic_ ? P.xs_ctx + (size_t)(b_ * CTXL + p_) * D : P.xs_lat + (size_t)(b_ * SEQ + p_ - CTXL) * D; \
            _Pragma("unroll") for (int q = 0; q < 4; ++q) x_[q] = *(const f32x4*)(sp_ + q * 256 + c0); } \
        else { _Pragma("unroll") for (int q = 0; q < 4; ++q) b_x[q] = *(const u32x2*)(F.XB + (size_t)(r_) * D + q * 256 + c0); } \
        if (P.Y) { _Pragma("unroll") for (int q = 0; q < 4; ++q) y_[q] = *(const u32x2*)(P.Y + (size_t)(r_) * D + q * 256 + c0); } } while (0)
#pragma unroll
    for (int q = 0; q < 4; ++q) { yc[q] = (u32x2){0u, 0u}; yn[q] = yc[q]; yl[q] = yc[q]; bc[q] = yc[q]; bn[q] = yc[q]; bl[q] = yc[q]; xc[q] = (f32x4){0.f, 0.f, 0.f, 0.f}; xn[q] = xc[q]; xl[q] = xc[q]; }
    if (rb < re) RP_LOAD(rb, xc, yc, bc);
    if (rb + 1 < re) RP_LOAD(rb + 1, xn, yn, bn);
    for (int r = rb; r < re; ++r) {
        if (r + 2 < re) RP_LOAD(r + 2, xl, yl, bl);
        const int b = r / RPB, p = r % RPB; const bool isctx = p < CTXL; const int v = isctx ? 2 : b;
        if (!(isctx && P.skip_ctx)) {
            if (v != curv) { curv = v;
#pragma unroll
                for (int q = 0; q < 4; ++q) { const int col = q * 256 + c0;
                    if (P.Y) { const f32x4 g = *(const f32x4*)(P.gate + v * 6144 + col), gy = *(const f32x4*)(P.gy + col); gg[q] = g * gy; }
                    if (P.writeA) { const f32x4 gn = *(const f32x4*)(P.gn + col), sc = *(const f32x4*)(P.sc + v * 6144 + col); gs[q] = gn * (sc + 1.f); shv[q] = *(const f32x4*)(P.sh + v * 6144 + col); } } }
            f32x4 x[4];
#pragma unroll
            for (int q = 0; q < 4; ++q) { if (SRCF32) x[q] = xc[q]; else { float f[4]; unpack4(bc[q], f); x[q] = (f32x4){f[0], f[1], f[2], f[3]}; } }
            if (P.Y) {
                float y[16]; float ss = 0.f;
#pragma unroll
                for (int q = 0; q < 4; ++q) unpack4(yc[q], y + 4 * q);
#pragma unroll
                for (int i = 0; i < 16; ++i) ss += y[i] * y[i];
                ss = wave_sum(ss); const float rstd = rsqrtf(ss * (1.f / D) + EPS);
#pragma unroll
                for (int q = 0; q < 4; ++q) {
#pragma unroll
                    for (int jj = 0; jj < 4; ++jj) x[q][jj] += gg[q][jj] * (y[4 * q + jj] * rstd); }
                if (P.out_f32) { float* dst = F.out + (size_t)(b * SEQ + p - CTXL) * D;
#pragma unroll
                    for (int q = 0; q < 4; ++q) *(f32x4*)(dst + q * 256 + c0) = x[q]; }
                else {
#pragma unroll
                    for (int q = 0; q < 4; ++q) { u32x2 w; w.x = pk2(x[q][0], x[q][1]); w.y = pk2(x[q][2], x[q][3]); *(u32x2*)(F.XB + (size_t)r * D + q * 256 + c0) = w;
                        float f[4]; unpack4(w, f); x[q] = (f32x4){f[0], f[1], f[2], f[3]}; } }
            }
            if (P.writeA) {
                float ss = 0.f;
#pragma unroll
                for (int q = 0; q < 4; ++q)
#pragma unroll
                    for (int jj = 0; jj < 4; ++jj) ss += x[q][jj] * x[q][jj];
                ss = wave_sum(ss); const float rstd = rsqrtf(ss * (1.f / D) + EPS);
#pragma unroll
                for (int q = 0; q < 4; ++q) { float o[4];
#pragma unroll
                    for (int jj = 0; jj < 4; ++jj) o[jj] = x[q][jj] * rstd * gs[q][jj] + shv[q][jj];
                    u32x2 w; w.x = pk2(o[0], o[1]); w.y = pk2(o[2], o[3]); *(u32x2*)(F.A + (size_t)r * D + q * 256 + c0) = w; }
            }
        }
#pragma unroll
        for (int q = 0; q < 4; ++q) { xc[q] = xn[q]; yc[q] = yn[q]; xn[q] = xl[q]; yn[q] = yl[q]; bc[q] = bn[q]; bn[q] = bl[q]; }
    }
  }
#undef RP_LOAD
}

struct SguPre { u32x4 v0, v1; u32x2 up[4]; float bias; };
DEV void sgu_prefetch(const Fr& F, int l, int it, SguPre& P) {
    const int b = it / 520, ch = (it >> 2) % NCH, h = it & 3; const int row0 = b * RPB + ch * 128;
    const int tid = F.tid, w = F.wave, fr = F.lane & 15, fq = F.lane >> 4;
    const int t = tid >> 2, part = tid & 3; const bf16_t* zp = F.Z + (size_t)(row0 + t) * ZS + ZC_SGU + 256 + h * 64 + part * 16;
    P.v0 = *(const u32x4*)zp; P.v1 = *(const u32x4*)(zp + 8);
#pragma unroll
    for (int nt = 0; nt < 4; ++nt) P.up[nt] = *(const u32x2*)(F.Z + (size_t)(row0 + 16 * w + fr) * ZS + ZC_SGU + h * 64 + 16 * nt + 4 * fq);
    P.bias = F.in[I_SGUB][(l * 4 + h) * 128 + 16 * w + fr];
}
DEV void sgu_phase(const Fr& F, int l, int it0) {
    LAS bf16_t* Ws = (LAS bf16_t*)F.lds;
    LAS bf16_t* Vh = Ws + 128 * 136;
    const int tid = F.tid, w = F.wave, fr = F.lane & 15, fq = F.lane >> 4;
    int it = it0; while (it < 1040 && (l + 1 == DEPTH && (it >> 2) % NCH < 2)) it += F.G;
    if (it >= 1040) return;
    int h = -1;
    SguPre P; sgu_prefetch(F, l, it, P);
    while (it < 1040) {
        if ((it & 3) != h) { h = it & 3; const float* W = F.in[I_SGUW] + (size_t)(l * 4 + h) * 128 * 128;
#pragma unroll
          for (int i = 0; i < 8; ++i) { const int idx = tid + NTHR * i; const int t = idx >> 5, s4 = (idx & 31) * 4; const f32x4 v = *(const f32x4*)(W + idx * 4);
              u32x2 o; o.x = pk2(v[0], v[1]); o.y = pk2(v[2], v[3]); *(LAS u32x2*)(Ws + t * 136 + s4) = o; } }
        int nx = it + F.G; while (nx < 1040 && (l + 1 == DEPTH && (nx >> 2) % NCH < 2)) nx += F.G;
        const int b = it / 520, ch = (it >> 2) % NCH; const int row0 = b * RPB + ch * 128;
        { const int t = tid >> 2, part = tid & 3;
          float x[16]; unpack8(P.v0, x); unpack8(P.v1, x + 8);
          float s = 0.f;
#pragma unroll
          for (int i = 0; i < 16; ++i) { x[i] = fgelu(x[i]); s += x[i]; }
          s += __shfl_xor(s, 1); s += __shfl_xor(s, 2); const float mu = s * (1.f / 64.f);
          float q = 0.f;
#pragma unroll
          for (int i = 0; i < 16; ++i) { x[i] -= mu; q += x[i] * x[i]; }
          q += __shfl_xor(q, 1); q += __shfl_xor(q, 2); const float rstd = rsqrtf(q * (1.f / 64.f) + EPS);
#pragma unroll
          for (int i = 0; i < 16; i += 2) *(LAS unsigned*)(Vh + t * 72 + part * 16 + i) = pk2(x[i] * rstd, x[i + 1] * rstd); }
        u32x2 up[4];
#pragma unroll
        for (int nt = 0; nt < 4; ++nt) up[nt] = P.up[nt];
        const float bias = P.bias;
        __syncthreads();
        if (nx < 1040) sgu_prefetch(F, l, nx, P);
        f32x4 acc[4];
#pragma unroll
        for (int nt = 0; nt < 4; ++nt) { acc[nt] = (f32x4){0.f, 0.f, 0.f, 0.f};
#pragma unroll
            for (int k0 = 0; k0 < 128; k0 += 32) { const bf16x8 xf = *(const LAS bf16x8*)(Ws + (16 * w + fr) * 136 + k0 + fq * 8); const bf16x8 yf = tr_frag(Vh, 72, k0, 16 * nt, F.lane);
                acc[nt] = __builtin_amdgcn_mfma_f32_16x16x32_bf16(yf, xf, acc[nt], 0, 0, 0); } }
        { const int t = 16 * w + fr;
#pragma unroll
          for (int nt = 0; nt < 4; ++nt) { const int d0 = 16 * nt + 4 * fq; float u[4]; unpack4(up[nt], u);
              float o[4];
#pragma unroll
              for (int j = 0; j < 4; ++j) o[j] = fgelu(u[j]) * (acc[nt][j] + bias);
              u32x2 wv; wv.x = pk2(o[0], o[1]); wv.y = pk2(o[2], o[3]); *(u32x2*)(F.MIX + (size_t)(row0 + t) * D + h * 64 + d0) = wv; } }
        __syncthreads();
        it = nx;
    }
}

struct PoolPre { u32x4 r[3]; };
DEV void pool_prefetch(const Fr& F, int it, PoolPre& P) {
    const int b = it / 520, ch = (it >> 2) % NCH, g = it & 3; const int tid = F.tid;
    const bool isctx = ch < 2; const int seqlen = isctx ? CTXL : SEQ; const int p0 = isctx ? ch * 128 : (ch - 2) * 128; const int seqrow0 = b * RPB + (isctx ? 0 : CTXL);
#pragma unroll
    for (int i = 0; i < 3; ++i) { const int idx = tid + NTHR * i; const int rr = idx >> 3, c8 = (idx & 7) * 8; const int p = p0 - 8 + rr; P.r[i] = (u32x4){0u, 0u, 0u, 0u};
        if (idx < 144 * 8 && p >= 0 && p < seqlen) P.r[i] = *(const u32x4*)(F.Z + (size_t)(seqrow0 + p) * ZS + ZC_POOL + g * 64 + c8); }
}
DEV void pool_phase(const Fr& F, int l, int it0, int stride) {
    LAS float* Zt = (LAS float*)F.lds;
    LAS bf16_t* Dm = (LAS bf16_t*)(F.lds + 144 * 64 * 4);
    LAS bf16_t* Wp = Dm + 128 * 72;
    const int tid = F.tid, w = F.wave, fr = F.lane & 15, fq = F.lane >> 4;
    int it = it0; while (it < 1040 && (l + 1 == DEPTH && (it >> 2) % NCH < 2)) it += stride;
    if (it >= 1040) return;
    int g = -1;
    PoolPre P; pool_prefetch(F, it, P);
    while (it < 1040) {
        int nx = it + stride; while (nx < 1040 && (l + 1 == DEPTH && (nx >> 2) % NCH < 2)) nx += stride;
        const int b = it / 520, ch = (it >> 2) % NCH;
        if ((it & 3) != g) { g = it & 3;
#pragma unroll
            for (int i = 0; i < 2; ++i) { const int idx = tid + NTHR * i; const int c = idx >> 4, d4 = (idx & 15) * 4; const f32x4 v = *(const f32x4*)(F.in[I_POOLW] + (size_t)(l * 4 + g) * 4096 + idx * 4);
                u32x2 o; o.x = pk2(v[0], v[1]); o.y = pk2(v[2], v[3]); *(LAS u32x2*)(Wp + c * 72 + d4) = o; } }
        const bool isctx = ch < 2; const int seqlen = isctx ? CTXL : SEQ; const int p0 = isctx ? ch * 128 : (ch - 2) * 128; const int row0 = b * RPB + ch * 128;
        const int win = 2 << g, half = win >> 1;
#pragma unroll
        for (int i = 0; i < 3; ++i) { const int idx = tid + NTHR * i; if (idx < 144 * 8) { const int rr = idx >> 3, c8 = (idx & 7) * 8; float x[8]; unpack8(P.r[i], x);
#pragma unroll
            for (int j = 0; j < 8; ++j) Zt[rr * 64 + c8 + j] = x[j]; } }
        __syncthreads();
        if (nx < 1040) pool_prefetch(F, nx, P);
        { const int t = tid >> 2, part = tid & 3; const int p = p0 + t; const int lo = max(p - half, 0), hi = min(p + win - half, seqlen); const float rc = 1.f / (float)(hi - lo);
          float s[16];
#pragma unroll
          for (int j = 0; j < 16; ++j) s[j] = 0.f;
          for (int o = -half; o < half; ++o) {
#pragma unroll
              for (int j = 0; j < 16; ++j) s[j] += Zt[(t + 8 + o) * 64 + part * 16 + j]; }
#pragma unroll
          for (int j = 0; j < 16; j += 2) { const float a0 = s[j] * rc - Zt[(t + 8) * 64 + part * 16 + j], a1 = s[j + 1] * rc - Zt[(t + 8) * 64 + part * 16 + j + 1];
              *(LAS unsigned*)(Dm + t * 72 + part * 16 + j) = pk2(a0, a1); } }
        __syncthreads();
        f32x4 acc[4];
#pragma unroll
        for (int nt = 0; nt < 4; ++nt) { acc[nt] = (f32x4){0.f, 0.f, 0.f, 0.f};
#pragma unroll
            for (int k0 = 0; k0 < 64; k0 += 32) { const bf16x8 xf = *(const LAS bf16x8*)(Dm + (16 * w + fr) * 72 + k0 + fq * 8); const bf16x8 yf = tr_frag(Wp, 72, k0, 16 * nt, F.lane);
                acc[nt] = __builtin_amdgcn_mfma_f32_16x16x32_bf16(yf, xf, acc[nt], 0, 0, 0); } }
        { const int t = 16 * w + fr;
#pragma unroll
          for (int nt = 0; nt < 4; ++nt) { const int d0 = 16 * nt + 4 * fq; const f32x4 ps = *(const f32x4*)(F.in[I_POOLS] + l * 256 + g * 64 + d0);
              u32x2 wv; wv.x = pk2(acc[nt][0] * ps[0], acc[nt][1] * ps[1]); wv.y = pk2(acc[nt][2] * ps[2], acc[nt][3] * ps[3]);
              *(u32x2*)(F.MIX + (size_t)(row0 + t) * D + 768 + g * 64 + d0) = wv; } }
        __syncthreads();
        it = nx;
    }
}

DEV void load_rope8(const Fr& F, const bf16_t* zp, int c8, int n, bool rope, float* o) {
    unpack8(*(const u32x4*)(zp + c8), o);
    if (rope) {
        const bool second = (c8 & 16) != 0; float pr[8]; unpack8(*(const u32x4*)(zp + (second ? c8 - 16 : c8 + 16)), pr);
        const int pos = (c8 >= 32) ? (n & 63) : (n >> 6); const float* tb = F.ROPE + (size_t)(pos * 16 + (c8 & 8)) * 2;
#pragma unroll
        for (int e = 0; e < 8; ++e) { const float c = tb[2 * e], s = tb[2 * e + 1]; o[e] = second ? (o[e] * c + pr[e] * s) : (o[e] * c - pr[e] * s); }
    }
}
DEV bf16x8 pack8(const float* x) { u32x4 o; o.x = pk2(x[0], x[1]); o.y = pk2(x[2], x[3]); o.z = pk2(x[4], x[5]); o.w = pk2(x[6], x[7]); return __builtin_bit_cast(bf16x8, o); }
DEV void attn_item(const Fr& F, int l, int b, int qb, int kvh, bool ctxq) {
    LAS bf16_t* Ks = (LAS bf16_t*)F.lds;
    LAS bf16_t* Vs = Ks + 128 * 72;
    LAS bf16_t* Ps = Vs + 128 * 72;
    const int tid = F.tid, w = F.wave, fr = F.lane & 15, fq = F.lane >> 4;
    const int qrow0 = b * RPB + (ctxq ? qb * 128 : CTXL + qb * 128);
    const int g = w >> 2, rq = w & 3, r0 = rq * 32;
    bf16x8 xq[2][2];
#pragma unroll
    for (int mt = 0; mt < 2; ++mt)
#pragma unroll
        for (int ks = 0; ks < 2; ++ks) { const int t = r0 + 16 * mt + fr; float x[8];
            load_rope8(F, F.Z + (size_t)(qrow0 + t) * ZS + ZC_AQ + (kvh * 2 + g) * 64, 32 * ks + 8 * fq, qb * 128 + t, !ctxq, x);
#pragma unroll
            for (int e = 0; e < 8; ++e) x[e] *= 0.18033688011f;
            xq[mt][ks] = pack8(x); }
    const float sink = F.in[I_SINK][l * 4 + kvh * 2 + g] * 1.44269504089f;
    float mrow[2], lrow[2]; f32x4 O[2][4];
#pragma unroll
    for (int mt = 0; mt < 2; ++mt) { mrow[mt] = sink; lrow[mt] = 1.f;
#pragma unroll
        for (int n = 0; n < 4; ++n) O[mt][n] = (f32x4){0.f, 0.f, 0.f, 0.f}; }
    LAS bf16_t* Pw = Ps + w * 32 * 136;
    const int ktl[5] = {0, 1, 2, 3, 4};
    int kt = 0; const int nkt = ctxq ? 2 : 5;
    u32x4 rk[2], rp[2], rv[2];
    auto tile_ok = [&](int k) { const int kb = qb + k - 3; return k < 2 || (kb >= 0 && kb < SEQ / 128); };
#define ATT_PREFETCH(k) do { const int kb_ = qb + (k) - 3; const int krow0_ = b * RPB + ((k) < 2 ? (k) * 128 : CTXL + kb_ * 128); \
        _Pragma("unroll") for (int i = 0; i < 2; ++i) { const int idx = tid + NTHR * i; const int s_ = idx >> 3, c8 = (idx & 7) * 8; \
            const bf16_t* zp = F.Z + (size_t)(krow0_ + s_) * ZS + ZC_AK + kvh * 64; \
            rk[i] = *(const u32x4*)(zp + c8); rp[i] = *(const u32x4*)(zp + ((c8 & 16) ? c8 - 16 : c8 + 16)); \
            rv[i] = *(const u32x4*)(F.Z + (size_t)(krow0_ + s_) * ZS + ZC_AV + kvh * 64 + c8); } } while (0)
    (void)ktl;
    while (kt < nkt && !tile_ok(kt)) ++kt;
    if (kt < nkt) ATT_PREFETCH(kt);
    while (kt < nkt) {
        const int kb = qb + kt - 3; const bool rope = kt >= 2;
        __syncthreads();
#pragma unroll
        for (int i = 0; i < 2; ++i) { const int idx = tid + NTHR * i; const int s_ = idx >> 3, c8 = (idx & 7) * 8;
            float x[8]; unpack8(rk[i], x);
            if (rope) { float pr[8]; unpack8(rp[i], pr); const bool second = (c8 & 16) != 0; const int n = kb * 128 + s_;
                const int pos = (c8 >= 32) ? (n & 63) : (n >> 6); const float* tb = F.ROPE + (size_t)(pos * 16 + (c8 & 8)) * 2;
#pragma unroll
                for (int e = 0; e < 8; ++e) { const float c = tb[2 * e], sn = tb[2 * e + 1]; x[e] = second ? (x[e] * c + pr[e] * sn) : (x[e] * c - pr[e] * sn); } }
            *(LAS bf16x8*)(Ks + s_ * 72 + c8) = pack8(x);
            *(LAS u32x4*)(Vs + s_ * 72 + c8) = rv[i]; }
        __syncthreads();
        int kn = kt + 1; while (kn < nkt && !tile_ok(kn)) ++kn;
        if (kn < nkt) ATT_PREFETCH(kn);
        const int nlo = (kt == 2) ? 2 * rq : 0, nhi = (kt == 4) ? 2 * rq + 2 : 8;
        f32x4 sc[2][8];
#pragma unroll
        for (int nt = 0; nt < 8; ++nt) { if (nt >= nlo && nt < nhi) {
            const bf16x8 y0 = *(const LAS bf16x8*)(Ks + (nt * 16 + fr) * 72 + 8 * fq), y1 = *(const LAS bf16x8*)(Ks + (nt * 16 + fr) * 72 + 32 + 8 * fq);
#pragma unroll
            for (int mt = 0; mt < 2; ++mt) { f32x4 a = __builtin_amdgcn_mfma_f32_16x16x32_bf16(y0, xq[mt][0], (f32x4){0.f, 0.f, 0.f, 0.f}, 0, 0, 0);
                sc[mt][nt] = __builtin_amdgcn_mfma_f32_16x16x32_bf16(y1, xq[mt][1], a, 0, 0, 0); } }
            else { sc[0][nt] = (f32x4){0.f, 0.f, 0.f, 0.f}; sc[1][nt] = sc[0][nt]; } }
        float scl[2];
#pragma unroll
        for (int mt = 0; mt < 2; ++mt) {
            const int tl = r0 + mt * 16 + fr;
            float mx = -INFINITY;
#pragma unroll
            for (int nt = 0; nt < 8; ++nt) { if (nt >= nlo && nt < nhi) {
                const bool dg = (kt == 2 || kt == 4) && (nt == 2 * rq + mt);
                if (dg) {
#pragma unroll
                    for (int j = 0; j < 4; ++j) { const int si = nt * 16 + 4 * fq + j; const bool ok = (kt == 2) ? (si >= tl) : (si <= tl); sc[mt][nt][j] = ok ? sc[mt][nt][j] : -INFINITY; } }
                else if ((kt == 2 && nt < 2 * rq + mt) || (kt == 4 && nt > 2 * rq + mt)) sc[mt][nt] = (f32x4){-INFINITY, -INFINITY, -INFINITY, -INFINITY};
                mx = fmaxf(fmaxf(mx, fmaxf(sc[mt][nt][0], sc[mt][nt][1])), fmaxf(sc[mt][nt][2], sc[mt][nt][3])); } }
            mx = fmaxf(mx, __shfl_xor(mx, 16)); mx = fmaxf(mx, __shfl_xor(mx, 32));
            const float mn = fmaxf(mrow[mt], mx); scl[mt] = __builtin_amdgcn_exp2f(mrow[mt] - mn);
            float sum = 0.f;
#pragma unroll
            for (int nt = 0; nt < 8; ++nt) { if (nt >= nlo && nt < nhi) { float p[4];
#pragma unroll
                for (int j = 0; j < 4; ++j) { p[j] = __builtin_amdgcn_exp2f(sc[mt][nt][j] - mn); sum += p[j]; }
                u32x2 pw; pw.x = pk2(p[0], p[1]); pw.y = pk2(p[2], p[3]); *(LAS u32x2*)(Pw + (mt * 16 + fr) * 136 + nt * 16 + 4 * fq) = pw; } }
            sum += __shfl_xor(sum, 16); sum += __shfl_xor(sum, 32);
            lrow[mt] = lrow[mt] * scl[mt] + sum; mrow[mt] = mn;
#pragma unroll
            for (int n2 = 0; n2 < 4; ++n2) O[mt][n2] *= scl[mt];
        }
        __builtin_amdgcn_wave_barrier();
        const int clo = nlo >> 1, chi = nhi >> 1;
#pragma unroll
        for (int c = 0; c < 4; ++c) { if (c >= clo && c < chi) {
            const bf16x8 p0 = *(const LAS bf16x8*)(Pw + fr * 136 + 32 * c + 8 * fq), p1 = *(const LAS bf16x8*)(Pw + (16 + fr) * 136 + 32 * c + 8 * fq);
#pragma unroll
            for (int n2 = 0; n2 < 4; ++n2) { const bf16x8 vf = tr_frag(Vs, 72, 32 * c, 16 * n2, F.lane);
                O[0][n2] = __builtin_amdgcn_mfma_f32_16x16x32_bf16(vf, p0, O[0][n2], 0, 0, 0); O[1][n2] = __builtin_amdgcn_mfma_f32_16x16x32_bf16(vf, p1, O[1][n2], 0, 0, 0); } } }
        __builtin_amdgcn_wave_barrier();
        kt = kn;
    }
#undef ATT_PREFETCH
#pragma unroll
    for (int mt = 0; mt < 2; ++mt) { const int t = r0 + mt * 16 + fr; const float rl = 1.f / lrow[mt];
#pragma unroll
        for (int n2 = 0; n2 < 4; ++n2) { u32x2 wv; wv.x = pk2(O[mt][n2][0] * rl, O[mt][n2][1] * rl); wv.y = pk2(O[mt][n2][2] * rl, O[mt][n2][3] * rl);
            *(u32x2*)(F.MIX + (size_t)(qrow0 + t) * D + 512 + (kvh * 2 + g) * 64 + n2 * 16 + 4 * fq) = wv; } }
    __syncthreads();
}

struct GateV { float li0, li1, bc0, bc1; };
struct GateRaw { float li0, li1, lp0, lp1; };
DEV GateRaw ml_gates_load(const Fr& F, int l, int row0, int h, int dir, int lane) {
    const int u0 = 2 * lane, u1 = u0 + 1; const int s0 = dir ? 127 - u0 : u0, s1 = dir ? 127 - u1 : u1;
    const float bi = F.in[I_GATEB][l * 16 + (dir * 2) * 4 + h], bf = F.in[I_GATEB][l * 16 + (dir * 2 + 1) * 4 + h];
    const bf16_t* z0 = F.Z + (size_t)(row0 + s0) * ZS + ZC_MG, * z1 = F.Z + (size_t)(row0 + s1) * ZS + ZC_MG;
    GateRaw r; r.li0 = bf2f(z0[(dir * 2) * 4 + h]) + bi; r.li1 = bf2f(z1[(dir * 2) * 4 + h]) + bi;
    r.lp0 = bf2f(z0[(dir * 2 + 1) * 4 + h]) + bf; r.lp1 = bf2f(z1[(dir * 2 + 1) * 4 + h]) + bf; return r;
}
DEV GateV ml_gates_fin(const GateRaw& g, int lane) {
    GateV r; r.li0 = g.li0; r.li1 = g.li1;
    const float lf0 = logsigmoid(g.lp0), lf1 = logsigmoid(g.lp1);
    const float incl = wave_scan_add(lf0 + lf1, lane);
    r.bc1 = incl; r.bc0 = incl - lf1; return r;
}
DEV void conv_silu8(const Fr& F, int seqrow0, int seqlen, int p, int zc, const float* cw, float scale, float* o) {
    float a[8], x[8];
#pragma unroll
    for (int j = 0; j < 8; ++j) a[j] = 0.f;
#pragma unroll
    for (int tap = 0; tap < 3; ++tap) { const int pp = p + tap - 1; if (pp >= 0 && pp < seqlen) { unpack8(*(const u32x4*)(F.Z + (size_t)(seqrow0 + pp) * ZS + zc), x);
        const f32x4 w0 = *(const f32x4*)(cw + tap * 512), w1 = *(const f32x4*)(cw + tap * 512 + 4);
#pragma unroll
        for (int j = 0; j < 4; ++j) { a[j] += x[j] * w0[j]; a[4 + j] += x[4 + j] * w1[j]; } } }
#pragma unroll
    for (int j = 0; j < 8; ++j) o[j] = fsilu(a[j]) * scale;
}

DEV void ml_local_item(const Fr& F, int l, int b, int ch, int h) {
    LAS bf16_t* Vs = (LAS bf16_t*)F.lds;
    LAS bf16_t* KTf = Vs + 128 * 72;
    LAS bf16_t* KTb = KTf + 128 * 72;
    LAS float* wv = (LAS float*)(KTb + 128 * 72);
    const int tid = F.tid, w = F.wave, lane = F.lane, fr = lane & 15, fq = lane >> 4;
    const bool isctx = ch < 2; const int seqlen = isctx ? CTXL : SEQ; const int p0 = isctx ? ch * 128 : (ch - 2) * 128;
    const int seqrow0 = b * RPB + (isctx ? 0 : CTXL); const int row0 = b * RPB + ch * 128;
    GateRaw graw; graw.li0 = graw.li1 = graw.lp0 = graw.lp1 = 0.f;
    if (w < 2) graw = ml_gates_load(F, l, row0, h, w, lane);
    u32x4 vv[2]; float kk[2][8];
#pragma unroll
    for (int i = 0; i < 2; ++i) { const int idx = tid + NTHR * i; const int s = idx >> 3, c8 = (idx & 7) * 8;
        vv[i] = *(const u32x4*)(F.Z + (size_t)(row0 + s) * ZS + ZC_MV + h * 64 + c8);
        conv_silu8(F, seqrow0, seqlen, p0 + s, ZC_MK + h * 64 + c8, F.in[I_CONVW] + l * 1536 + 256 + h * 64 + c8, 0.125f, kk[i]);
        *(bf16x8*)(F.A + (size_t)(row0 + s) * 256 + h * 64 + c8) = pack8(kk[i]); }
    if (w < 2) { const int dir = w; const GateV gv = ml_gates_fin(graw, lane);
        const float a0 = gv.li0 - gv.bc0, a1 = gv.li1 - gv.bc1; const float A = wave_max(fmaxf(a0, a1));
        const int u0 = 2 * lane; const int s0 = dir ? 127 - u0 : u0, s1 = dir ? 126 - u0 : u0 + 1;
        wv[dir * 128 + s0] = __expf(a0 - A); wv[dir * 128 + s1] = __expf(a1 - A);
        const int chain = dir * 8 + b * 4 + h;
        if (lane == 63) { F.AL[chain * NCH + ch] = A; F.BE[chain * NCH + ch] = gv.bc1; } }
    __syncthreads();
#pragma unroll
    for (int i = 0; i < 2; ++i) { const int idx = tid + NTHR * i; const int s = idx >> 3, c8 = (idx & 7) * 8;
        *(LAS u32x4*)(Vs + s * 72 + c8) = vv[i];
        const float wf = wv[s], wb = wv[128 + s];
        float kf[8], kb[8];
#pragma unroll
        for (int j = 0; j < 8; ++j) { kf[j] = kk[i][j] * wf; kb[j] = kk[i][j] * wb; }
        *(LAS bf16x8*)(KTf + s * 72 + c8) = pack8(kf); *(LAS bf16x8*)(KTb + s * 72 + c8) = pack8(kb); }
    __syncthreads();
    { const int dir = w >> 2, mt = w & 3; const int chain = dir * 8 + b * 4 + h; float* cl = F.CL + ((size_t)chain * NCH + ch) * 4096;
      const LAS bf16_t* KT = dir ? KTb : KTf;
      bf16x8 vfr[4];
#pragma unroll
      for (int c = 0; c < 4; ++c) vfr[c] = tr_frag(Vs, 72, 32 * c, 16 * mt, lane);
#pragma unroll
      for (int nt = 0; nt < 4; ++nt) { f32x4 acc = (f32x4){0.f, 0.f, 0.f, 0.f};
#pragma unroll
          for (int c = 0; c < 4; ++c) acc = __builtin_amdgcn_mfma_f32_16x16x32_bf16(tr_frag(KT, 72, 32 * c, 16 * nt, lane), vfr[c], acc, 0, 0, 0);
          *(f32x4*)(cl + (16 * mt + fr) * 64 + 16 * nt + 4 * fq) = acc; } }
    if (tid < 128) { const int dir = tid >> 6, d = tid & 63; const LAS bf16_t* KT = (dir ? KTb : KTf) + d; float s = 0.f;
        for (int i = 0; i < 128; ++i) s += bf2f(KT[i * 72]);
        const int chain = dir * 8 + b * 4 + h; F.NL[((size_t)chain * NCH + ch) * 64 + d] = s; }
    __syncthreads();
}

DEV int scan_order(int dir, int i) { return dir == 0 ? i : (i == 0 ? 1 : (i == 1 ? 0 : 131 - i)); }
DEV void ml_scan(const Fr& F) {
    const int gidx = F.bid * NTHR + F.tid;
    if (gidx >= 16 * 4160) return;
    const int chain = gidx / 4160, e = gidx % 4160, dir = chain >> 3;
    float* base; int stride;
    if (e < 4096) { base = F.CL + (size_t)chain * NCH * 4096 + e; stride = 4096; } else { base = F.NL + (size_t)chain * NCH * 64 + (e - 4096); stride = 64; }
    const float* al = F.AL + chain * NCH; const float* be = F.BE + chain * NCH; float* ms = F.MS + chain * NCH;
    float st = 0.f, m = 0.f;
    for (int i0 = 0; i0 < NCH; i0 += 26) {
        float v[26], A[26], B[26];
#pragma unroll
        for (int u = 0; u < 26; ++u) { const int cc = scan_order(dir, i0 + u); v[u] = base[(size_t)cc * stride]; A[u] = al[cc]; B[u] = be[cc]; }
#pragma unroll
        for (int u = 0; u < 26; ++u) { const int cc = scan_order(dir, i0 + u); const float Ml = fmaxf(m, A[u]); const float dec = __expf(m - Ml), scl = __expf(A[u] - Ml);
            base[(size_t)cc * stride] = st; if (e == 0) ms[cc] = m;
            st = dec * st + scl * v[u]; m = B[u] + Ml; }
    }
}

typedef float f32x2 __attribute__((ext_vector_type(2)));
DEV f32x2 fsilu2(f32x2 a) { const f32x2 t = a * -1.44269504089f; f32x2 e; e.x = __builtin_amdgcn_exp2f(t.x); e.y = __builtin_amdgcn_exp2f(t.y); const f32x2 d = e + 1.0f;
    f32x2 r; r.x = __builtin_amdgcn_rcpf(d.x); r.y = __builtin_amdgcn_rcpf(d.y); return a * r; }
struct MoPre { u32x4 v[2], k[2], q[2][3]; f32x4 ct[4]; GateRaw g; float mp, nvv; };
DEV void ml_out_prefetch(const Fr& F, int l, int it, MoPre& P) {
    const int b = it / 520, ch = (it >> 2) % NCH, h = it & 3;
    const int tid = F.tid, w = F.wave, lane = F.lane;
    const bool isctx = ch < 2; const int seqlen = isctx ? CTXL : SEQ; const int p0 = isctx ? ch * 128 : (ch - 2) * 128;
    const int seqrow0 = b * RPB + (isctx ? 0 : CTXL); const int row0 = b * RPB + ch * 128;
    P.g.li0 = P.g.li1 = P.g.lp0 = P.g.lp1 = 0.f; P.mp = 0.f;
    if (w < 2) { P.g = ml_gates_load(F, l, row0, h, w, lane); P.mp = F.MS[(w * 8 + b * 4 + h) * NCH + ch]; }
#pragma unroll
    for (int i = 0; i < 2; ++i) { const int idx = tid + NTHR * i; const int s = idx >> 3, c8 = (idx & 7) * 8;
        P.v[i] = *(const u32x4*)(F.Z + (size_t)(row0 + s) * ZS + ZC_MV + h * 64 + c8);
        P.k[i] = *(const u32x4*)(F.A + (size_t)(row0 + s) * 256 + h * 64 + c8);
#pragma unroll
        for (int tap = 0; tap < 3; ++tap) { const int pp = p0 + s + tap - 1; P.q[i][tap] = (u32x4){0u, 0u, 0u, 0u};
            if (pp >= 0 && pp < seqlen) P.q[i][tap] = *(const u32x4*)(F.Z + (size_t)(seqrow0 + pp) * ZS + ZC_MQ + h * 64 + c8); } }
#pragma unroll
    for (int i = 0; i < 4; ++i) { const int idx = tid + NTHR * i; const int dir = idx >> 10, e = (idx >> 4) & 63, d4 = (idx & 15) * 4; const int chain = dir * 8 + b * 4 + h;
        P.ct[i] = *(const f32x4*)(F.CL + ((size_t)chain * NCH + ch) * 4096 + e * 64 + d4); }
    P.nvv = 0.f;
    if (tid < 128) { const int dir = tid >> 6, d = tid & 63; const int chain = dir * 8 + b * 4 + h; P.nvv = F.NL[((size_t)chain * NCH + ch) * 64 + d]; }
}
DEV void ml_out_item(const Fr& F, int l, int it, MoPre& P, int nx) {
    const int b = it / 520, ch = (it >> 2) % NCH, h = it & 3;
    LAS bf16_t* Qs = (LAS bf16_t*)F.lds;
    LAS bf16_t* Ks = Qs + 128 * 72;
    LAS bf16_t* Vs = Ks + 128 * 72;
    LAS bf16_t* CT = Vs + 128 * 72;
    LAS bf16_t* Ps = CT + 2 * 64 * 72;
    LAS float* gvv = (LAS float*)(Ps + 8 * 16 * 136);
    LAS float* nv = gvv + 2 * 4 * 128;
    const int tid = F.tid, w = F.wave, lane = F.lane, fr = lane & 15, fq = lane >> 4;
    const int row0 = b * RPB + ch * 128;
    u32x2 ogp[4]; f32x4 ngp[4];
#pragma unroll
    for (int n2 = 0; n2 < 4; ++n2) { const int e0 = 16 * n2 + 4 * fq; ogp[n2] = *(const u32x2*)(F.Z + (size_t)(row0 + 16 * w + fr) * ZS + ZC_MO + h * 64 + e0); ngp[n2] = *(const f32x4*)(F.in[I_MNORMG] + l * 256 + h * 64 + e0); }
    if (w < 2) { const int dir = w; const GateV gv = ml_gates_fin(P.g, lane); const float mp = P.mp;
        const float a0 = gv.li0 - gv.bc0, a1 = gv.li1 - gv.bc1;
        const float cm = wave_scan_max(fmaxf(a0, a1), lane); const float cmprev = cummax_prev(cm);
        const float M0 = fmaxf(mp, fmaxf(cmprev, a0)), M1 = fmaxf(mp, cm);
        const int u0 = 2 * lane; const int s0 = dir ? 127 - u0 : u0, s1 = dir ? 126 - u0 : u0 + 1;
        LAS float* gb = gvv + dir * 512;
        gb[s0] = a0 * 1.44269504089f; gb[s1] = a1 * 1.44269504089f; gb[128 + s0] = M0 * 1.44269504089f; gb[128 + s1] = M1 * 1.44269504089f; gb[256 + s0] = __expf(mp - M0); gb[256 + s1] = __expf(mp - M1);
        gb[384 + s0] = __expf(-gv.bc0 - M0); gb[384 + s1] = __expf(-gv.bc1 - M1); }
#pragma unroll
    for (int i = 0; i < 2; ++i) { const int idx = tid + NTHR * i; const int s = idx >> 3, c8 = (idx & 7) * 8;
        *(LAS u32x4*)(Vs + s * 72 + c8) = P.v[i];
        *(LAS u32x4*)(Ks + s * 72 + c8) = P.k[i];
        const float* cw = F.in[I_CONVW] + l * 1536 + h * 64 + c8;
        f32x2 a[4]; float x[8];
#pragma unroll
        for (int q = 0; q < 4; ++q) a[q] = (f32x2){0.f, 0.f};
#pragma unroll
        for (int tap = 0; tap < 3; ++tap) { unpack8(P.q[i][tap], x); const f32x4 w0 = *(const f32x4*)(cw + tap * 512), w1 = *(const f32x4*)(cw + tap * 512 + 4);
            a[0] += (f32x2){x[0], x[1]} * (f32x2){w0[0], w0[1]}; a[1] += (f32x2){x[2], x[3]} * (f32x2){w0[2], w0[3]};
            a[2] += (f32x2){x[4], x[5]} * (f32x2){w1[0], w1[1]}; a[3] += (f32x2){x[6], x[7]} * (f32x2){w1[2], w1[3]}; }
        float k[8];
#pragma unroll
        for (int q = 0; q < 4; ++q) { const f32x2 r = fsilu2(a[q]); k[2 * q] = r.x; k[2 * q + 1] = r.y; }
        *(LAS bf16x8*)(Qs + s * 72 + c8) = pack8(k); }
#pragma unroll
    for (int i = 0; i < 4; ++i) { const int idx = tid + NTHR * i; const int dir = idx >> 10, e = (idx >> 4) & 63, d4 = (idx & 15) * 4;
        u32x2 o; o.x = pk2(P.ct[i][0], P.ct[i][1]); o.y = pk2(P.ct[i][2], P.ct[i][3]); *(LAS u32x2*)(CT + (dir * 64 + e) * 72 + d4) = o; }
    if (tid < 128) nv[tid] = P.nvv;
    __syncthreads();
    if (nx >= 0) ml_out_prefetch(F, l, nx, P);
    const int t = 16 * w + fr;
    f32x4 S[8];
#pragma unroll
    for (int nt = 0; nt < 8; ++nt) S[nt] = mma_nt<64>(Qs + 16 * w * 72, 72, Ks + 16 * nt * 72, 72, (f32x4){0.f, 0.f, 0.f, 0.f}, fr, fq);
    float qn0 = 0.f, qn1 = 0.f;
    { float q[16]; unpack8(*(const LAS u32x4*)(Qs + t * 72 + fq * 16), q); unpack8(*(const LAS u32x4*)(Qs + t * 72 + fq * 16 + 8), q + 8);
#pragma unroll
      for (int j = 0; j < 16; ++j) { qn0 += q[j] * nv[fq * 16 + j]; qn1 += q[j] * nv[64 + fq * 16 + j]; }
      qn0 += __shfl_xor(qn0, 16); qn0 += __shfl_xor(qn0, 32); qn1 += __shfl_xor(qn1, 16); qn1 += __shfl_xor(qn1, 32); }
    LAS bf16_t* Pw = Ps + w * 16 * 136;
    f32x4 hs[4];
#pragma unroll
    for (int n2 = 0; n2 < 4; ++n2) hs[n2] = (f32x4){0.f, 0.f, 0.f, 0.f};
#pragma unroll
    for (int dir = 0; dir < 2; ++dir) {
        const LAS float* gb = gvv + dir * 512;
        const float Mt = gb[128 + t], inter = gb[256 + t], em = gb[384 + t];
        float den = 0.f;
#pragma unroll
        for (int nt = 0; nt < 8; ++nt) { const bool full = dir ? (nt > w) : (nt < w); const bool diag = (nt == w);
            if (full || diag) { const f32x4 av = *(const LAS f32x4*)(gb + nt * 16 + 4 * fq); float p[4];
#pragma unroll
                for (int j = 0; j < 4; ++j) p[j] = S[nt][j] * __builtin_amdgcn_exp2f(av[j] - Mt);
                if (diag) {
#pragma unroll
                    for (int j = 0; j < 4; ++j) { const int si = nt * 16 + 4 * fq + j; const bool ok = dir ? (si >= t) : (si <= t); p[j] = ok ? p[j] : 0.f; } }
                den += (p[0] + p[1]) + (p[2] + p[3]);
                u32x2 pw; pw.x = pk2(p[0], p[1]); pw.y = pk2(p[2], p[3]); *(LAS u32x2*)(Pw + fr * 136 + nt * 16 + 4 * fq) = pw; }
            else if (nt == (w ^ 1)) *(LAS u32x2*)(Pw + fr * 136 + nt * 16 + 4 * fq) = (u32x2){0u, 0u}; }
        den += __shfl_xor(den, 16); den += __shfl_xor(den, 32);
        den += inter * (dir ? qn1 : qn0);
        const float rd = 1.f / fmaxf(fabsf(den), em);
        __builtin_amdgcn_wave_barrier();
        f32x4 acc[4];
#pragma unroll
        for (int n2 = 0; n2 < 4; ++n2) { acc[n2] = mma_nt<64>(Qs + 16 * w * 72, 72, CT + (dir * 64 + 16 * n2) * 72, 72, (f32x4){0.f, 0.f, 0.f, 0.f}, fr, fq); acc[n2] *= inter; }
#pragma unroll
        for (int c = 0; c < 4; ++c) { if (dir ? (c >= (w >> 1)) : (c <= (w >> 1))) {
            const bf16x8 pf = *(const LAS bf16x8*)(Pw + fr * 136 + 32 * c + 8 * fq);
#pragma unroll
            for (int n2 = 0; n2 < 4; ++n2) acc[n2] = __builtin_amdgcn_mfma_f32_16x16x32_bf16(tr_frag(Vs, 72, 32 * c, 16 * n2, lane), pf, acc[n2], 0, 0, 0); } }
#pragma unroll
        for (int n2 = 0; n2 < 4; ++n2) hs[n2] += acc[n2] * rd;
        __builtin_amdgcn_wave_barrier();
    }
    { float s = 0.f;
#pragma unroll
      for (int n2 = 0; n2 < 4; ++n2)
#pragma unroll
          for (int j = 0; j < 4; ++j) s += hs[n2][j];
      s += __shfl_xor(s, 16); s += __shfl_xor(s, 32); const float mu = s * (1.f / 64.f);
      float q = 0.f;
#pragma unroll
      for (int n2 = 0; n2 < 4; ++n2)
#pragma unroll
          for (int j = 0; j < 4; ++j) { hs[n2][j] -= mu; q += hs[n2][j] * hs[n2][j]; }
      q += __shfl_xor(q, 16); q += __shfl_xor(q, 32); const float rstd = rsqrtf(q * (1.f / 64.f) + EPS);
#pragma unroll
      for (int n2 = 0; n2 < 4; ++n2) { const int e0 = 16 * n2 + 4 * fq; const f32x4 ng = ngp[n2];
          float og[4]; unpack4(ogp[n2], og);
          float o[4];
#pragma unroll
          for (int j = 0; j < 4; ++j) o[j] = hs[n2][j] * rstd * ng[j] * fsigmoid(og[j]);
          u32x2 wv; wv.x = pk2(o[0], o[1]); wv.y = pk2(o[2], o[3]); *(u32x2*)(F.MIX + (size_t)(row0 + t) * D + 256 + h * 64 + e0) = wv; } }
    __syncthreads();
}


#define XB_TMO      128
#define XB_XCNT(j)  (256  + 64 * (j))
#define XB_XSUB(j)  (1280 + 64 * (j))
#define XB_XGEN(j)  (2304 + 64 * (j))
#define XB_TOP      3328
#define XB_TOPGEN   3392
#define XCD_BAR_WORDS 3456
#define XB_SPIN_CAP (1u << 22)
DEV unsigned xb_ld(unsigned* p)              { return __hip_atomic_load(p, __ATOMIC_RELAXED, __HIP_MEMORY_SCOPE_AGENT); }
DEV unsigned xb_add(unsigned* p, unsigned v) { return __hip_atomic_fetch_add(p, v, __ATOMIC_RELAXED, __HIP_MEMORY_SCOPE_AGENT); }
DEV unsigned xb_xcc_id() { return (unsigned)__builtin_amdgcn_s_getreg((3 << 11) | 20) & 0xFu; }
#define XB_SPIN(cond, bar) do { unsigned _sp = 0; while (cond) { __builtin_amdgcn_s_sleep(1); \
    if ((++_sp & 255u) == 0u) { if (xb_ld(&(bar)[XB_TMO])) break; if (_sp > XB_SPIN_CAP) { atomicAdd(&(bar)[XB_TMO], 1u); break; } } } } while (0)
struct XcdBarrier { unsigned* bar; unsigned x; volatile LAS unsigned* st; };
DEV XcdBarrier xcd_barrier_post(unsigned* bar, volatile LAS unsigned* st) {
    XcdBarrier b; b.bar = bar; b.x = xb_xcc_id(); b.st = st;
    if (threadIdx.x == 0) st[2] = xb_add(&bar[XB_XCNT(b.x)], 1u);
    return b;
}
DEV void xcd_barrier_complete(unsigned* bar, unsigned x, unsigned& nloc, unsigned& nx) {
    const unsigned G = gridDim.x * gridDim.y * gridDim.z;
    unsigned sum, cnt, mine, sp = 0u;
    for (;;) {
        sum = 0u; cnt = 0u; mine = 0u;
#pragma unroll
        for (unsigned j = 0; j < 16; ++j) { const unsigned c = xb_ld(&bar[XB_XCNT(j)]); sum += c; cnt += (c > 0u) ? 1u : 0u; mine = (j == x) ? c : mine; }
        if (sum == G) break;
        __builtin_amdgcn_s_sleep(1);
        if ((++sp & 255u) == 0u) { if (xb_ld(&bar[XB_TMO])) break; if (sp > XB_SPIN_CAP) { atomicAdd(&bar[XB_TMO], 1u); break; } }
    }
    nloc = mine > 0u ? mine : 1u; nx = cnt > 0u ? cnt : 1u;
}
DEV void xcd_barrier(const XcdBarrier& b) {
    asm volatile("s_waitcnt vmcnt(0)" ::: "memory");
    __syncthreads();
    if (threadIdx.x == 0) {
        unsigned* bar = b.bar;
        __builtin_amdgcn_s_waitcnt(0);
        unsigned nloc = b.st[0], nx = b.st[1];
        if (nloc == 0u) { xcd_barrier_complete(bar, b.x, nloc, nx); b.st[0] = nloc; b.st[1] = nx; }
        const unsigned old = xb_add(&bar[XB_XSUB(b.x)], 1u);
        const unsigned gen = old / nloc;
        if (old + 1u == (gen + 1u) * nloc) {
            __builtin_amdgcn_fence(__ATOMIC_RELEASE, "agent");
            asm volatile("s_waitcnt vmcnt(0)" ::: "memory");
            const unsigned og = xb_add(&bar[XB_TOP], 1u);
            const unsigned tg = og / nx;
            if (og + 1u == (tg + 1u) * nx) xb_add(&bar[XB_TOPGEN], 1u);
            else XB_SPIN(xb_ld(&bar[XB_TOPGEN]) == tg, bar);
            __builtin_amdgcn_fence(__ATOMIC_ACQUIRE, "agent");
            xb_add(&bar[XB_XGEN(b.x)], 1u);
            asm volatile("s_waitcnt vmcnt(0)" ::: "memory");
        } else {
            XB_SPIN(xb_ld(&bar[XB_XGEN(b.x)]) == gen, bar);
            __builtin_amdgcn_fence(__ATOMIC_ACQUIRE, "agent");
            asm volatile("s_waitcnt vmcnt(0)" ::: "memory");
        }
    }
    __syncthreads();
}


#define XB_LSUB(j) (3584 + 64 * (j))
DEV void xcd_local_barrier(const XcdBarrier& b) {
    asm volatile("s_waitcnt vmcnt(0)" ::: "memory");
    __syncthreads();
    if (threadIdx.x == 0) {
        unsigned* c = b.bar + XB_LSUB(b.x);
        __builtin_amdgcn_s_waitcnt(0);
        const unsigned old = xb_add(c, 1u); const unsigned target = (old / 32u + 1u) * 32u;
        XB_SPIN(xb_ld(c) < target, b.bar);
        __builtin_amdgcn_fence(__ATOMIC_ACQUIRE, "agent");
        asm volatile("s_waitcnt vmcnt(0)" ::: "memory");
    }
    __syncthreads();
}

#define CG_LOOP(NCB, CALL) do { if (F.px) { const int rb = F.xq; for (int cb = F.rk; cb < (NCB); cb += 32) { CALL; } } else if (F.G == 256) { const int xcd_ = F.bid & 7; for (int it2 = F.bid >> 3; ; it2 += 32) { const int cb = xcd_ + 8 * (it2 >> 3); if (cb >= (NCB)) break; const int rb = it2 & 7; CALL; } } \
        else { for (int it = F.bid; it < 8 * (NCB); it += F.G) { const int rb = it / (NCB), cb = it % (NCB); CALL; } } } while (0)
#define SEAM_LOCAL() do { if (F.px) xcd_local_barrier(xbar); else xcd_barrier(xbar); RETID(); } while (0)
#define RETID() do { int t_ = threadIdx.x; asm volatile("" : "+v"(t_)); F.tid = t_; F.lane = t_ & 63; F.wave = __builtin_amdgcn_readfirstlane(t_ >> 6); } while (0)
__global__ void __launch_bounds__(NTHR, 2) fwd_megakernel(Args args) {
    extern __shared__ __attribute__((aligned(16))) unsigned char lds_raw[];
    cg::grid_group grid = cg::this_grid();
    Fr F;
#pragma unroll
    for (int i = 0; i < 19; ++i) F.in[i] = args.in[i];
    F.out = args.out; F.ws = args.ws;
    F.A = (bf16_t*)(F.ws + WS_A); F.Y = (bf16_t*)(F.ws + WS_Z); F.XB = (bf16_t*)(F.ws + WS_Y);     F.Z = (bf16_t*)(F.ws + WS_Z); F.MIX = (bf16_t*)(F.ws + WS_MIX); F.H = (bf16_t*)(F.ws + WS_H);
    F.CL = (float*)(F.ws + WS_CL); F.NL = (float*)(F.ws + WS_NL); F.AL = (float*)(F.ws + WS_SC); F.BE = F.AL + 16 * NCH; F.MS = F.BE + 16 * NCH;
    F.MOD = (float*)(F.ws + WS_MOD); F.CTXR = (float*)(F.ws + WS_CTXR); F.ROPE = (float*)(F.ws + WS_ROPE);
    F.lds = (LAS unsigned char*)lds_raw;
    RETID(); F.G = gridDim.x; F.bid = blockIdx.x;
    volatile LAS unsigned* xst = (volatile LAS unsigned*)(F.lds + 131072);
    if (F.tid < 4) xst[F.tid] = 0u;
    __syncthreads();
    const XcdBarrier xbar = xcd_barrier_post((unsigned*)(F.ws + WS_BAR), xst);

    F.px = 0; F.xq = (int)xbar.x; F.rk = 0;
    prologue_a(F);
    grid.sync(); RETID();
    { if (F.tid == 0) { unsigned* bw = (unsigned*)(F.ws + WS_BAR); unsigned ok = (F.G == 256) ? 1u : 0u;
          for (unsigned j = 0; j < 16; ++j) { const unsigned cj = xb_ld(&bw[XB_XCNT(j)]); if (cj != (j < 8 ? 32u : 0u)) ok = 0u; }
          xst[3] = ok; }
      __syncthreads(); F.px = (int)xst[3]; F.rk = (int)xst[2]; }
    { RowPass P{nullptr, F.in[I_X], F.in[I_CTX], false, nullptr, nullptr, F.in[I_NORMG], F.MOD, F.MOD + 1024, true, false}; rowpass<true>(F, P); }
    xcd_barrier(xbar); RETID();

    for (int l = 0; l < DEPTH; ++l) {
        const float* MODl = F.MOD + (size_t)l * 3 * 6144; const float* ng = F.in[I_NORMG] + l * 4 * D;
        { pg8::Gemm g{F.A, wt_ptr(F, l, 0), NB * SEQ, ZS, D}; pg8::StaticOrder S; S.init(NB * SEQ, ZS, F.G, F.bid); S.part(F.px, F.xq, F.rk); pg8::EpiBf16 E{F.Z, ZS}; pg8::gemm_phase(F.lds, F.tid, g, S, E); }
        RETID();
        CG_LOOP(37, cgemm_tile<0>(F, F.A, wt_ptr(F, l, 0), D, rb, cb, F.Z, ZS));
        xcd_barrier(xbar); RETID();
        for (int it = F.bid; it < 1040; it += F.G) ml_local_item(F, l, it / 520, (it >> 2) % NCH, it & 3);
        RETID();
        sgu_phase(F, l, (F.bid + 16 * F.G - 1040) % F.G);
        RETID();
        for (int it = (F.bid + 16 * F.G - 2080) % F.G; it < 8; it += F.G) { if (l + 1 == DEPTH) continue; attn_item(F, l, it >> 2, (it >> 1) & 1, it & 1, true); }
        xcd_barrier(xbar); RETID();
        ml_scan(F);
        RETID();
        { unsigned* qctr = (unsigned*)(F.ws + WS_BAR) + XCD_BAR_WORDS + 16 * l; volatile LAS unsigned* qs = (volatile LAS unsigned*)(F.lds + 131072 + 64);
          for (;;) { __syncthreads(); if (F.tid == 0) qs[0] = atomicAdd(qctr, 1u); __syncthreads(); const int it = (int)qs[0]; if (it >= 512 + 384) break;
              if (it < 512) attn_item(F, l, it >> 8, (it >> 1) & 127, it & 1, false);
              else pool_phase(F, l, it - 512, 4096); } }
        xcd_barrier(xbar); RETID();
        { int it = F.bid; while (it < 1040 && (l + 1 == DEPTH && (it >> 2) % NCH < 2)) it += F.G;
          if (it < 1040) { MoPre P; ml_out_prefetch(F, l, it, P);
              while (it < 1040) { int nx = it + F.G; while (nx < 1040 && (l + 1 == DEPTH && (nx >> 2) % NCH < 2)) nx += F.G;
                  ml_out_item(F, l, it, P, nx < 1040 ? nx : -1); it = nx; } } }
        RETID();
        if (F.bid >= 16) pool_phase(F, l, 384 + F.bid - 16, F.G - 16);
        xcd_barrier(xbar); RETID();
        { pg8::Gemm g{F.MIX, wt_ptr(F, l, 1), NB * SEQ, D, D}; pg8::StaticOrder S; S.init(NB * SEQ, D, F.G, F.bid); S.part(F.px, F.xq, F.rk); pg8::EpiBf16 E{F.Y, D}; pg8::gemm_phase(F.lds, F.tid, g, S, E); }
        RETID();
        if (l + 1 < DEPTH) CG_LOOP(16, cgemm_tile<0>(F, F.MIX, wt_ptr(F, l, 1), D, rb, cb, F.Y, D));
        SEAM_LOCAL();
        { RowPass P{F.Y, F.in[I_X], F.in[I_CTX], false, MODl + 2048, ng + D, ng + 2 * D, MODl + 3072, MODl + 4096, true, l + 1 == DEPTH}; if (l == 0) rowpass<true>(F, P); else rowpass<false>(F, P); }
        SEAM_LOCAL();
        { pg8::Gemm g{F.A, wt_ptr(F, l, 2), NB * SEQ, 2 * FH, D}; pg8::StaticOrder S; S.init(NB * SEQ, 2 * FH, F.G, F.bid); S.part(F.px, F.xq, F.rk); pg8::EpiSwiglu E{F.H}; pg8::gemm_phase(F.lds, F.tid, g, S, E); }
        RETID();
        if (l + 1 < DEPTH) CG_LOOP(88, cgemm_tile<1>(F, F.A, wt_ptr(F, l, 2), D, rb, cb, F.H, FH));
        SEAM_LOCAL();
        { pg8::Gemm g{F.H, wt_ptr(F, l, 3), NB * SEQ, D, FH}; pg8::StaticOrder S; S.init(NB * SEQ, D, F.G, F.bid); S.part(F.px, F.xq, F.rk); pg8::EpiBf16 E{F.A, D}; pg8::gemm_phase(F.lds, F.tid, g, S, E); }
        RETID();
        if (l + 1 < DEPTH) CG_LOOP(16, cgemm_tile<0>(F, F.H, wt_ptr(F, l, 3), FH, rb, cb, F.A, D));
        SEAM_LOCAL();
        { const bool lastl = (l == DEPTH - 1); const float* MODn = MODl + (lastl ? 0 : 3 * 6144); const float* ngn = ng + (lastl ? 0 : 4 * D);
          RowPass P{F.A, nullptr, nullptr, lastl, MODl + 5120, ng + 3 * D, ngn, MODn, MODn + 1024, !lastl, lastl}; rowpass<false>(F, P); }
        if (l + 1 < DEPTH) SEAM_LOCAL();
    }
}

extern "C" void kernel_launch(void* const* d_in, const int* in_sizes, int n_in, void* d_out, int out_size, void* d_ws, size_t ws_size, hipStream_t stream) {
    static int grid = 0;
    if (grid == 0) {
        if (n_in != 19 || ws_size < WS_END) { fprintf(stderr, "kernel_launch: need 19 inputs and >= %zu bytes of workspace (got %d, %zu)\n", (size_t)WS_END, n_in, ws_size); grid = -1; return; }
        int dev = 0, cus = 0, per_cu = 0;
        hipGetDevice(&dev); hipDeviceGetAttribute(&cus, hipDeviceAttributeMultiprocessorCount, dev);
        if (hipFuncSetAttribute((const void*)fwd_megakernel, hipFuncAttributeMaxDynamicSharedMemorySize, LDS_BYTES) != hipSuccess) { fprintf(stderr, "kernel_launch: hipFuncSetAttribute failed\n"); grid = -1; return; }
        if (hipOccupancyMaxActiveBlocksPerMultiprocessor(&per_cu, (const void*)fwd_megakernel, NTHR, LDS_BYTES) != hipSuccess || per_cu < 1) { fprintf(stderr, "kernel_launch: occupancy query gives %d\n", per_cu); per_cu = 1; }
        (void)hipGetLastError();
        grid = cus;
    }
    if (grid < 0) return;
    if (hipMemsetAsync((char*)d_ws + WS_BAR, 0, 16384, stream) != hipSuccess) { fprintf(stderr, "kernel_launch: memset failed\n"); return; }
    Args a{};
    for (int i = 0; i < 19; ++i) a.in[i] = (const float*)d_in[i];
    a.out = (float*)d_out; a.ws = (unsigned char*)d_ws;
    void* kargs[] = {&a};
    hipError_t e = hipLaunchCooperativeKernel((const void*)fwd_megakernel, dim3(grid), dim3(NTHR), kargs, LDS_BYTES, stream);
    if (e != hipSuccess) fprintf(stderr, "cooperative launch failed: %s (grid %d)\n", hipGetErrorString(e), grid);
}
```
